# Optimizing an MI355X kernel written in HIP

```python
import jax, jax.numpy as jnp
from jax import lax
import numpy as np

D_MODEL = 1024
BATCH = 2
SEQ = 8192
DEPTH = 2

D_A = 1024
CONV_A = 3
D_B = 1024
CONV_B = 31
D_C = 1024
N_HEADS_C = 8
HEAD_C = D_C // N_HEADS_C
CHUNK = 128
N_BRANCH = 3
SPLITS = (D_A, 2 * D_A, 3 * D_A, 3 * D_A + D_B, 3 * D_A + 2 * D_B, 3 * D_A + 2 * D_B + 2 * D_C)
D_IN = 3 * D_A + 2 * D_B + 2 * D_C + N_BRANCH * D_MODEL
N_GROUPS_MOE = 4
EXPERTS_PER_GROUP = 8
N_EXPERTS = N_GROUPS_MOE * EXPERTS_PER_GROUP
TOP_K = 2
D_FF_EXPERT = 512
MOE_BLOCK = 128
RMS_EPS = 1e-6
LN_EPS = 1e-5

kernel_name = "hybrid_conv_gmlp_hmoe_encoder"


def rms_norm(x, g):
    xf = x.astype(jnp.float32)
    y = xf * lax.rsqrt(jnp.mean(xf * xf, axis=-1, keepdims=True) + RMS_EPS)
    return (y * g.astype(jnp.float32)).astype(x.dtype)


def layer_norm(x, g, b):
    xf = x.astype(jnp.float32)
    mu = jnp.mean(xf, axis=-1, keepdims=True)
    var = jnp.mean(jnp.square(xf - mu), axis=-1, keepdims=True)
    y = (xf - mu) * lax.rsqrt(var + LN_EPS) * g.astype(jnp.float32) + b.astype(jnp.float32)
    return y.astype(x.dtype)


def depthwise_conv(x, w):
    k = w.shape[0]
    return lax.conv_general_dilated(
        x, w[:, None, :].astype(x.dtype), window_strides=(1,),
        padding=((k // 2, k // 2),), dimension_numbers=("NWC", "WIO", "NWC"),
        feature_group_count=x.shape[-1])


def short_conv_mixer(xa, ba, ca, w_conv, w_out):
    return (ba * depthwise_conv(ca * xa, w_conv)) @ w_out


def conformer_conv(val, gate, w_conv, ln_g, ln_b, w_out):
    z = val * jax.nn.sigmoid(gate)
    z = depthwise_conv(z, w_conv)
    z = jax.nn.silu(layer_norm(z, ln_g, ln_b))
    return z @ w_out


def chunked_spatial_gating(uv, ln_g, ln_b, w_s, b_s, w_out):
    uv = jax.nn.gelu(uv)
    u, v = jnp.split(uv, 2, axis=-1)
    v = layer_norm(v, ln_g, ln_b)
    bsz, s, _ = v.shape
    v = v.reshape(bsz, s // CHUNK, CHUNK, N_HEADS_C, HEAD_C)
    v = jnp.einsum("hpq,bnqhc->bnphc", w_s, v) + b_s.T[None, None, :, :, None]
    return (u * v.reshape(bsz, s, D_C)) @ w_out


def mixer_block(x, norm_g, w_in, conv_a, w_a_out, conv_b, ln_b_g, ln_b_b, w_b_out,
                ln_c_g, ln_c_b, w_s, b_s, w_c_out, w_o):
    bsz, s, d = x.shape
    h = rms_norm(x, norm_g)
    p = h @ w_in
    xa, ba, ca, val_b, gate_b, uv_c, gate_logits = jnp.split(p, SPLITS, axis=-1)
    y_a = short_conv_mixer(xa, ba, ca, conv_a, w_a_out)
    y_b = conformer_conv(val_b, gate_b, conv_b, ln_b_g, ln_b_b, w_b_out)
    y_c = chunked_spatial_gating(uv_c, ln_c_g, ln_c_b, w_s, b_s, w_c_out)
    g = jax.nn.sigmoid(gate_logits).reshape(bsz, s, N_BRANCH, d)
    merged = g[:, :, 0] * y_a + g[:, :, 1] * y_b + g[:, :, 2] * y_c
    return merged @ w_o


def hier_moe(h, w_group, b_group, w_router, b_router, w1, w3, w2):
    bsz, s, d = h.shape
    t = bsz * s
    hf = h.reshape(t, d)
    group_logits = (hf @ w_group + b_group).astype(jnp.float32)
    group_prob = jax.nn.softmax(group_logits, axis=-1)
    g_idx = jnp.argmax(group_logits, axis=-1)
    g_p = jnp.take_along_axis(group_prob, g_idx[:, None], axis=1)
    exp_logits = (hf @ w_router + b_router).astype(jnp.float32)
    exp_logits = exp_logits.reshape(t, N_GROUPS_MOE, EXPERTS_PER_GROUP)
    exp_logits = jnp.take_along_axis(exp_logits, g_idx[:, None, None], axis=1)[:, 0]
    top_logit, top_idx = lax.top_k(exp_logits, TOP_K)
    top_w = jax.nn.softmax(top_logit, axis=-1) * g_p
    n_assign = t * TOP_K
    expert = (g_idx[:, None] * EXPERTS_PER_GROUP + top_idx).reshape(-1).astype(jnp.int32)
    tok = jnp.repeat(jnp.arange(t, dtype=jnp.int32), TOP_K)
    wgt = top_w.reshape(-1).astype(h.dtype)
    order = jnp.argsort(expert)
    e_sorted = expert[order]
    tok_sorted = tok[order]
    w_sorted = wgt[order]
    counts = jnp.bincount(expert, length=N_EXPERTS)
    padded = (counts + MOE_BLOCK - 1) // MOE_BLOCK * MOE_BLOCK
    start = jnp.cumsum(counts) - counts
    padded_end = jnp.cumsum(padded)
    padded_start = padded_end - padded
    dest = padded_start[e_sorted] + jnp.arange(n_assign, dtype=jnp.int32) - start[e_sorted]
    n_blocks = n_assign // MOE_BLOCK + N_EXPERTS
    n_slots = n_blocks * MOE_BLOCK
    slot_tok = jnp.full((n_slots,), t, dtype=jnp.int32).at[dest].set(tok_sorted)
    slot_w = jnp.zeros((n_slots,), h.dtype).at[dest].set(w_sorted)
    block_start = jnp.arange(n_blocks, dtype=jnp.int32) * MOE_BLOCK
    block_expert = jnp.minimum(jnp.searchsorted(padded_end, block_start, side="right"), N_EXPERTS - 1)
    h_pad = jnp.concatenate([hf, jnp.zeros((1, d), h.dtype)], axis=0)
    xb = h_pad[slot_tok].reshape(n_blocks, MOE_BLOCK, d)

    def expert_block(args):
        xe, e = args
        return (jax.nn.silu(xe @ w1[e]) * (xe @ w3[e])) @ w2[e]

    yb = lax.map(expert_block, (xb, block_expert)).reshape(n_slots, d)
    y = jax.ops.segment_sum(yb * slot_w[:, None], slot_tok, num_segments=t + 1)[:t]
    return y.reshape(bsz, s, d)


def setup_inputs(seed: int = 0) -> dict:
    key = jax.random.key(seed)
    ks = jax.random.split(key, 26)

    def nrm(k, shape, scale):
        return jax.random.normal(k, shape, jnp.float32) * scale

    def gain(k, shape):
        return 1.0 + 0.02 * jax.random.normal(k, shape, jnp.float32)

    L, D = DEPTH, D_MODEL
    return {
        "x": nrm(ks[0], (BATCH, SEQ, D), 1.0),
        "norm_mix": gain(ks[1], (L, D)),
        "w_in": nrm(ks[2], (L, D, D_IN), D ** -0.5),
        "conv_a": nrm(ks[3], (L, CONV_A, D_A), CONV_A ** -0.5),
        "w_a_out": nrm(ks[4], (L, D_A, D), D_A ** -0.5),
        "conv_b": nrm(ks[5], (L, CONV_B, D_B), CONV_B ** -0.5),
        "ln_b_g": gain(ks[6], (L, D_B)),
        "ln_b_b": nrm(ks[7], (L, D_B), 0.02),
        "w_b_out": nrm(ks[8], (L, D_B, D), D_B ** -0.5),
        "ln_c_g": gain(ks[9], (L, D_C)),
        "ln_c_b": nrm(ks[10], (L, D_C), 0.02),
        "w_s": nrm(ks[11], (L, N_HEADS_C, CHUNK, CHUNK), CHUNK ** -0.5),
        "b_s": gain(ks[12], (L, N_HEADS_C, CHUNK)),
        "w_c_out": nrm(ks[13], (L, D_C, D), D_C ** -0.5),
        "w_o": nrm(ks[14], (L, D, D), D ** -0.5),
        "norm_ffn": gain(ks[15], (L, D)),
        "w_group": nrm(ks[16], (L, D, N_GROUPS_MOE), D ** -0.5),
        "b_group": nrm(ks[17], (L, N_GROUPS_MOE), 0.01),
        "w_router": nrm(ks[18], (L, D, N_EXPERTS), D ** -0.5),
        "b_router": nrm(ks[19], (L, N_EXPERTS), 0.01),
        "w1": nrm(ks[20], (L, N_EXPERTS, D, D_FF_EXPERT), D ** -0.5),
        "w3": nrm(ks[21], (L, N_EXPERTS, D, D_FF_EXPERT), D ** -0.5),
        "w2": nrm(ks[22], (L, N_EXPERTS, D_FF_EXPERT, D), D_FF_EXPERT ** -0.5),
        "norm_final": gain(ks[23], (D,)),
    }


def reference(x, norm_mix, w_in, conv_a, w_a_out, conv_b, ln_b_g, ln_b_b, w_b_out,
              ln_c_g, ln_c_b, w_s, b_s, w_c_out, w_o, norm_ffn, w_group, b_group,
              w_router, b_router, w1, w3, w2, norm_final):
    for l in range(DEPTH):
        x = x + mixer_block(x, norm_mix[l], w_in[l], conv_a[l], w_a_out[l], conv_b[l],
                            ln_b_g[l], ln_b_b[l], w_b_out[l], ln_c_g[l], ln_c_b[l],
                            w_s[l], b_s[l], w_c_out[l], w_o[l])
        x = x + hier_moe(rms_norm(x, norm_ffn[l]), w_group[l], b_group[l], w_router[l],
                         b_router[l], w1[l], w3[l], w2[l])
    return rms_norm(x, norm_final)
```

```cpp
#include <hip/hip_runtime.h>
#include <stdint.h>
#include <stdio.h>

#define LAS __attribute__((address_space(3)))
typedef unsigned short bf16_t;
typedef short bf16x8 __attribute__((ext_vector_type(8)));
typedef float f32x4 __attribute__((ext_vector_type(4)));
typedef float f32x2 __attribute__((ext_vector_type(2)));
typedef unsigned u32x4 __attribute__((ext_vector_type(4)));
typedef unsigned u32x2 __attribute__((ext_vector_type(2)));

constexpr int T = 16384, D = 1024, SEQ = 8192, DIN = 10240, NE = 32, NG = 4, EPG = 8, DFF = 512, NHC = 8;
constexpr int CAP = 16384;
constexpr int NL = 2;
constexpr float RMS_EPS = 1e-6f, LN_EPS = 1e-5f;

constexpr size_t MiB = 1u << 20;
constexpr size_t WS_CTL = 0, CTL_BYTES = 1 * MiB;
constexpr size_t WS_WIN = 2 * MiB, WS_WA = 22 * MiB, WS_WB = 24 * MiB, WS_WC = 26 * MiB, WS_WO = 28 * MiB, WS_W13 = 30 * MiB, WS_W2 = 94 * MiB;
constexpr size_t WS_H = 126 * MiB;
constexpr size_t WS_QA = 159 * MiB, WS_BA = 191 * MiB, WS_ZB = 223 * MiB, WS_U = 255 * MiB, WS_V = 287 * MiB, WS_G = 319 * MiB;
constexpr size_t WS_CB = 415 * MiB;
constexpr size_t WS_MB = 447 * MiB;
constexpr size_t WS_ACT = WS_QA;
constexpr size_t WS_YC = WS_ZB;
constexpr size_t WS_STOK = 511 * MiB, WS_SW = 513 * MiB, WS_SASG = 515 * MiB;
constexpr size_t WS_STAT = 517 * MiB;
constexpr size_t WS_END = 518 * MiB;
constexpr int CW_CNT = 0;

__device__ __forceinline__ unsigned cvt_pk_bf16(float lo, float hi) { unsigned r; asm volatile("v_cvt_pk_bf16_f32 %0, %1, %2" : "=v"(r) : "v"(lo), "v"(hi)); return r; }
__device__ __forceinline__ float bf_lo(unsigned p) { return __uint_as_float(p << 16); }
__device__ __forceinline__ float bf_hi(unsigned p) { return __uint_as_float(p & 0xffff0000u); }
__device__ __forceinline__ float wave_sum(float v) {
#pragma unroll
    for (int o = 1; o < 64; o <<= 1) v += __shfl_xor(v, o);
    return v;
}
__device__ __forceinline__ float sigmoidf_(float x) { return __builtin_amdgcn_rcpf(1.0f + __expf(-x)); }
__device__ __forceinline__ float siluf_(float x) { return x * sigmoidf_(x); }
__device__ __forceinline__ float gelu_tanh_(float x) { const float z = 0.7978845608028654f * (x + 0.044715f * x * x * x); return x * sigmoidf_(2.0f * z); }
__device__ __forceinline__ f32x4 sig4(f32x4 v) { return (f32x4){sigmoidf_(v[0]), sigmoidf_(v[1]), sigmoidf_(v[2]), sigmoidf_(v[3])}; }
__device__ __forceinline__ f32x4 silu4(f32x4 v) { return (f32x4){siluf_(v[0]), siluf_(v[1]), siluf_(v[2]), siluf_(v[3])}; }
__device__ __forceinline__ f32x4 gelu4(f32x4 v) { return (f32x4){gelu_tanh_(v[0]), gelu_tanh_(v[1]), gelu_tanh_(v[2]), gelu_tanh_(v[3])}; }
__device__ __forceinline__ void store4bf(bf16_t* p, f32x4 v) { u32x2 w; w.x = cvt_pk_bf16(v[0], v[1]); w.y = cvt_pk_bf16(v[2], v[3]); *(u32x2*)p = w; }
__device__ __forceinline__ f32x4 load4bf(const bf16_t* p) { const u32x2 w = *(const u32x2*)p; return (f32x4){bf_lo(w.x), bf_hi(w.x), bf_lo(w.y), bf_hi(w.y)}; }
__device__ __forceinline__ unsigned ld_agent(const unsigned* p) { return __hip_atomic_load(p, __ATOMIC_RELAXED, __HIP_MEMORY_SCOPE_AGENT); }

__device__ __forceinline__ int pair_col(int c) { return 32 * (c >> 6) + 16 * ((c >> 5) & 1) + (c & 15); }

struct Params {
    const float* in[24];
    float* out;
    unsigned char* ws;
    int layer, pad;
};
#define WSP(type, off) ((type*)(p.ws + (off)))

struct CvtDesc { const float* A; const float* B; bf16_t* dst; long sbatch, dbatch; int ld, K, ndst, pair, colA0, colB0, batch, items; };
constexpr int NCVT = 11;
struct CvtTable { CvtDesc d[NCVT]; int total, pad; };

__device__ __forceinline__ void cvt_item(const CvtDesc& c, int item, LAS float* tile  , int tid, int nthr) {
    const int ntn = c.ndst / 64, ntk = c.K / 64;
    const int b = item / (ntn * ntk), rem = item % (ntn * ntk), nb = rem / ntk, kb = rem % ntk, n0 = nb * 64, k0 = kb * 64;
    const float* A = c.A + (size_t)b * c.sbatch; const float* B = c.B ? c.B + (size_t)b * c.sbatch : nullptr; bf16_t* dst = c.dst + (size_t)b * c.dbatch;
    for (int idx = tid; idx < 4096; idx += nthr) {
        const int kk = idx >> 6, nl = idx & 63; const float* src; int col;
        if (c.pair) { const int sub = nl >> 4, i = nl & 15; src = (sub & 1) ? B : A; col = ((sub & 1) ? c.colB0 : c.colA0) + 32 * nb + 16 * (sub >> 1) + i; }
        else { src = A; col = c.colA0 + n0 + nl; }
        tile[kk * 65 + nl] = src[(size_t)(k0 + kk) * c.ld + col];
    }
    __syncthreads();
    for (int idx = tid; idx < 512; idx += nthr) {
        const int nl = idx >> 3, ch = idx & 7; const LAS float* s = tile + (8 * ch) * 65 + nl;
        u32x4 o; o.x = cvt_pk_bf16(s[0], s[65]); o.y = cvt_pk_bf16(s[2 * 65], s[3 * 65]); o.z = cvt_pk_bf16(s[4 * 65], s[5 * 65]); o.w = cvt_pk_bf16(s[6 * 65], s[7 * 65]);
        *(u32x4*)(dst + (size_t)(n0 + nl) * c.K + k0 + 8 * ch) = o;
    }
    __syncthreads();
}
__device__ __forceinline__ void cvt_phase(const CvtTable& tb, LAS float* tile, int bid, int nblk) {
    for (int it = bid; it < tb.total; it += nblk) {
        int r = it, di = 0;
        while (di < NCVT - 1 && r >= tb.d[di].items) { r -= tb.d[di].items; ++di; }
        cvt_item(tb.d[di], r, tile, threadIdx.x, blockDim.x);
    }
}
__global__ void __launch_bounds__(512) k_cvt(CvtTable tb) {
    __shared__ float tile[64 * 65];
    cvt_phase(tb, (LAS float*)tile, blockIdx.x, gridDim.x);
}

template <bool COMBINE, bool FINAL>
__device__ __forceinline__ void norm_phase(const float* xsrc, float* xbuf, const bf16_t* yc, const float* g, bf16_t* h, float* outf, int bid, int nblk) {
    const int lane = threadIdx.x & 63, wave = threadIdx.x >> 6, nw = blockDim.x >> 6;
    f32x4 gv[4];
#pragma unroll
    for (int j = 0; j < 4; ++j) gv[j] = *(const f32x4*)(g + 4 * lane + 256 * j);
    for (int row = bid * nw + wave; row < T; row += nblk * nw) {
        f32x4 v[4]; float ss = 0.f;
#pragma unroll
        for (int j = 0; j < 4; ++j) {
            v[j] = *(const f32x4*)(xsrc + (size_t)row * D + 4 * lane + 256 * j);
            if (COMBINE) { v[j] += load4bf(yc + (size_t)(2 * row) * D + 4 * lane + 256 * j); v[j] += load4bf(yc + (size_t)(2 * row + 1) * D + 4 * lane + 256 * j); }
            ss += (v[j][0] * v[j][0] + v[j][1] * v[j][1]) + (v[j][2] * v[j][2] + v[j][3] * v[j][3]);
        }
        const float rstd = rsqrtf(wave_sum(ss) * (1.0f / D) + RMS_EPS);
#pragma unroll
        for (int j = 0; j < 4; ++j) {
            if (COMBINE && !FINAL) *(f32x4*)(xbuf + (size_t)row * D + 4 * lane + 256 * j) = v[j];
            const f32x4 o = v[j] * rstd * gv[j];
            if (FINAL) *(f32x4*)(outf + (size_t)row * D + 4 * lane + 256 * j) = o;
            else store4bf(h + (size_t)row * D + 4 * lane + 256 * j, o);
        }
    }
}

__device__ __forceinline__ void router_phase(const float* xbuf, const float* g, const float* wg, const float* bg, const float* wr, const float* br,
                                             bf16_t* h2, unsigned* cnt, int* slot_tok, float* slot_w, int* slot_asg, int bid, int nblk) {
    const int lane = threadIdx.x & 63, wave = threadIdx.x >> 6, nw = blockDim.x >> 6;
    if (bid == 0) for (int i = threadIdx.x; i < D / 2; i += blockDim.x) ((unsigned*)(h2 + (size_t)T * D))[i] = 0u;
    f32x4 gv[4];
#pragma unroll
    for (int j = 0; j < 4; ++j) gv[j] = *(const f32x4*)(g + 4 * lane + 256 * j);
    for (int row = bid * nw + wave; row < T; row += nblk * nw) {
        f32x4 v[4]; float ss = 0.f;
#pragma unroll
        for (int j = 0; j < 4; ++j) { v[j] = *(const f32x4*)(xbuf + (size_t)row * D + 4 * lane + 256 * j); ss += (v[j][0] * v[j][0] + v[j][1] * v[j][1]) + (v[j][2] * v[j][2] + v[j][3] * v[j][3]); }
        const float rstd = rsqrtf(wave_sum(ss) * (1.0f / D) + RMS_EPS);
        float lg[NG], le[NE];
#pragma unroll
        for (int i = 0; i < NG; ++i) lg[i] = 0.f;
#pragma unroll
        for (int i = 0; i < NE; ++i) le[i] = 0.f;
#pragma unroll
        for (int j = 0; j < 4; ++j) {
            v[j] = v[j] * rstd * gv[j];
            store4bf(h2 + (size_t)row * D + 4 * lane + 256 * j, v[j]);
#pragma unroll
            for (int e = 0; e < 4; ++e) {
                const int k = 4 * lane + 256 * j + e; const float hk = v[j][e];
                const f32x4 a = *(const f32x4*)(wg + (size_t)k * NG);
#pragma unroll
                for (int i = 0; i < 4; ++i) lg[i] += hk * a[i];
#pragma unroll
                for (int q = 0; q < 8; ++q) { const f32x4 b = *(const f32x4*)(wr + (size_t)k * NE + 4 * q);
#pragma unroll
                    for (int i = 0; i < 4; ++i) le[4 * q + i] += hk * b[i]; }
                asm volatile("" ::: "memory");
            }
        }
#pragma unroll
        for (int i = 0; i < NG; ++i) lg[i] = wave_sum(lg[i]) + bg[i];
#pragma unroll
        for (int i = 0; i < NE; ++i) le[i] = wave_sum(le[i]) + br[i];
        int gi = 0; float gm = lg[0];
#pragma unroll
        for (int i = 1; i < NG; ++i) if (lg[i] > gm) { gm = lg[i]; gi = i; }
        float gs = 0.f;
#pragma unroll
        for (int i = 0; i < NG; ++i) gs += __expf(lg[i] - gm);
        const float gp = 1.0f / gs;
        float el[EPG];
#pragma unroll
        for (int i = 0; i < EPG; ++i) { el[i] = le[i];
#pragma unroll
            for (int q = 1; q < NG; ++q) el[i] = (gi == q) ? le[q * EPG + i] : el[i]; }
        int i0 = 0; float m0 = el[0];
#pragma unroll
        for (int i = 1; i < EPG; ++i) if (el[i] > m0) { m0 = el[i]; i0 = i; }
        int i1 = -1; float m1 = -3.0e38f;
#pragma unroll
        for (int i = 0; i < EPG; ++i) if (i != i0 && el[i] > m1) { m1 = el[i]; i1 = i; }
        const float ex = __expf(m1 - m0); const float w0 = gp / (1.0f + ex), w1 = gp * ex / (1.0f + ex);
        if (lane == 0) {
            const int e0 = gi * EPG + i0, e1 = gi * EPG + i1;
            const unsigned r0 = atomicAdd(cnt + e0, 1u), r1 = atomicAdd(cnt + e1, 1u);
            slot_tok[e0 * CAP + r0] = row; slot_w[e0 * CAP + r0] = w0; slot_asg[e0 * CAP + r0] = 2 * row;
            slot_tok[e1 * CAP + r1] = row; slot_w[e1 * CAP + r1] = w1; slot_asg[e1 * CAP + r1] = 2 * row + 1;
        }
    }
}

__device__ __forceinline__ void midA_phase(const bf16_t* QA, bf16_t* BA, const float* cw  , int bid, int nblk) {
    const int nthr = blockDim.x;
    for (int idx = bid * nthr + threadIdx.x; idx < T * (D / 8); idx += nblk * nthr) {
        const int t = idx >> 7, c = (idx & 127) * 8, s = t & (SEQ - 1);
        const u32x4 z = {0u, 0u, 0u, 0u};
        const u32x4 q1 = *(const u32x4*)(QA + (size_t)t * D + c);
        u32x4 q0 = *(const u32x4*)(QA + (size_t)(s > 0 ? t - 1 : t) * D + c);
        u32x4 q2 = *(const u32x4*)(QA + (size_t)(s < SEQ - 1 ? t + 1 : t) * D + c);
        q0 = s > 0 ? q0 : z; q2 = s < SEQ - 1 ? q2 : z;
        const u32x4 bb = *(const u32x4*)(BA + (size_t)t * D + c);
        u32x4 o;
#pragma unroll
        for (int j = 0; j < 4; ++j) {
            const int c0 = c + 2 * j;
            const float lo = bf_lo(bb[j]) * (cw[c0] * bf_lo(q0[j]) + cw[D + c0] * bf_lo(q1[j]) + cw[2 * D + c0] * bf_lo(q2[j]));
            const float hi = bf_hi(bb[j]) * (cw[c0 + 1] * bf_hi(q0[j]) + cw[D + c0 + 1] * bf_hi(q1[j]) + cw[2 * D + c0 + 1] * bf_hi(q2[j]));
            o[j] = cvt_pk_bf16(lo, hi);
        }
        *(u32x4*)(BA + (size_t)t * D + c) = o;
    }
}
__device__ __forceinline__ void midB_conv_phase(const bf16_t* ZB, bf16_t* CB, const float* cw  , int bid, int nblk) {
    for (int cp = threadIdx.x; cp < D / 2; cp += blockDim.x) {
        f32x2 w[31];
#pragma unroll
        for (int j = 0; j < 31; ++j) w[j] = *(const f32x2*)(cw + j * D + 2 * cp);
        for (int tg = bid; tg < T / 16; tg += nblk) {
            const int t0 = tg * 16, s0 = t0 & (SEQ - 1);
            f32x2 acc[16];
#pragma unroll
            for (int o = 0; o < 16; ++o) acc[o] = (f32x2){0.f, 0.f};
#pragma unroll
            for (int i = 0; i < 46; ++i) {
                const int s = s0 - 15 + i;
                const bool ok = (s >= 0 && s < SEQ);
                unsigned xv = *(const unsigned*)(ZB + (size_t)(ok ? t0 - 15 + i : t0) * D + 2 * cp);
                xv = ok ? xv : 0u;
                const f32x2 x = {bf_lo(xv), bf_hi(xv)};
#pragma unroll
                for (int o = 0; o < 16; ++o) { const int j = i - o; if (j >= 0 && j < 31) acc[o] += w[j] * x; }
            }
#pragma unroll
            for (int o = 0; o < 16; ++o) *(unsigned*)(CB + (size_t)(t0 + o) * D + 2 * cp) = cvt_pk_bf16(acc[o][0], acc[o][1]);
        }
    }
}
__device__ __forceinline__ void row16_load(const bf16_t* rowp, int lane, float (&x)[16]) {
    const u32x4 a = *(const u32x4*)(rowp + 8 * lane), b = *(const u32x4*)(rowp + 512 + 8 * lane);
#pragma unroll
    for (int j = 0; j < 4; ++j) { x[2 * j] = bf_lo(a[j]); x[2 * j + 1] = bf_hi(a[j]); x[8 + 2 * j] = bf_lo(b[j]); x[8 + 2 * j + 1] = bf_hi(b[j]); }
}
__device__ __forceinline__ void row16_stats(const float (&x)[16], float& mean, float& rstd) {
    float s = 0.f;
#pragma unroll
    for (int j = 0; j < 16; ++j) s += x[j];
    mean = wave_sum(s) * (1.0f / D);
    float q = 0.f;
#pragma unroll
    for (int j = 0; j < 16; ++j) { const float d = x[j] - mean; q += d * d; }
    rstd = rsqrtf(wave_sum(q) * (1.0f / D) + LN_EPS);
}
__device__ __forceinline__ void midB_ln_phase(bf16_t* CB, const float* g, const float* b, int bid, int nblk) {
    const int lane = threadIdx.x & 63, wave = threadIdx.x >> 6, nw = blockDim.x >> 6;
    float gg[16], bb[16];
#pragma unroll
    for (int j = 0; j < 8; ++j) { gg[j] = g[8 * lane + j]; gg[8 + j] = g[512 + 8 * lane + j]; bb[j] = b[8 * lane + j]; bb[8 + j] = b[512 + 8 * lane + j]; }
    for (int row = bid * nw + wave; row < T; row += nblk * nw) {
        float x[16], mean, rstd; row16_load(CB + (size_t)row * D, lane, x); row16_stats(x, mean, rstd);
        u32x4 o0, o1;
#pragma unroll
        for (int j = 0; j < 4; ++j) {
            o0[j] = cvt_pk_bf16(siluf_((x[2 * j] - mean) * rstd * gg[2 * j] + bb[2 * j]), siluf_((x[2 * j + 1] - mean) * rstd * gg[2 * j + 1] + bb[2 * j + 1]));
            o1[j] = cvt_pk_bf16(siluf_((x[8 + 2 * j] - mean) * rstd * gg[8 + 2 * j] + bb[8 + 2 * j]), siluf_((x[8 + 2 * j + 1] - mean) * rstd * gg[8 + 2 * j + 1] + bb[8 + 2 * j + 1]));
        }
        *(u32x4*)(CB + (size_t)row * D + 8 * lane) = o0; *(u32x4*)(CB + (size_t)row * D + 512 + 8 * lane) = o1;
    }
}
__device__ __forceinline__ void midC_stats_phase(const bf16_t* V, float* stat, int bid, int nblk) {
    const int lane = threadIdx.x & 63, wave = threadIdx.x >> 6, nw = blockDim.x >> 6;
    for (int row = bid * nw + wave; row < T; row += nblk * nw) {
        float x[16], mean, rstd; row16_load(V + (size_t)row * D, lane, x); row16_stats(x, mean, rstd);
        if (lane == 0) *(f32x2*)(stat + 2 * row) = (f32x2){mean, rstd};
    }
}
constexpr int MC_LD = 272;
constexpr int MC_LDS_BYTES = 2 * 128 * MC_LD;
__device__ __forceinline__ void midC_gate_phase(const bf16_t* V, bf16_t* U, const float* stat, const float* lng, const float* lnb, const float* Ws, const float* bs,
                                                LAS unsigned char* lds, int bid, int nblk) {
    const int tid = threadIdx.x, lane = tid & 63, wid = tid >> 6, wr = wid >> 2, wc = wid & 3, fr = lane & 15, fq = lane >> 4;
    LAS unsigned char* SA = lds; LAS unsigned char* SB = lds + 128 * MC_LD;
    for (int unit = bid; unit < (T / 128) * NHC; unit += nblk) {
        const int n = unit >> 3, h = unit & 7, t0 = n * 128;
        for (int idx = tid; idx < 2048; idx += 512) {
            const int pr = idx >> 4, q8 = idx & 15; const float* s = Ws + ((size_t)h * 128 + pr) * 128 + q8 * 8;
            const f32x4 a = *(const f32x4*)s, b = *(const f32x4*)(s + 4);
            u32x4 o; o.x = cvt_pk_bf16(a[0], a[1]); o.y = cvt_pk_bf16(a[2], a[3]); o.z = cvt_pk_bf16(b[0], b[1]); o.w = cvt_pk_bf16(b[2], b[3]);
            *(LAS u32x4*)(SA + pr * MC_LD + q8 * 16) = o;
        }
        for (int idx = tid; idx < 2048; idx += 512) {
            const int q = idx & 127, c8 = idx >> 7, c0 = h * 128 + c8 * 8;
            const u32x4 vv = *(const u32x4*)(V + (size_t)(t0 + q) * D + c0);
            const f32x2 st = *(const f32x2*)(stat + 2 * (t0 + q));
#pragma unroll
            for (int j = 0; j < 4; ++j) {
                const float y0 = (bf_lo(vv[j]) - st.x) * st.y * lng[c0 + 2 * j] + lnb[c0 + 2 * j];
                const float y1 = (bf_hi(vv[j]) - st.x) * st.y * lng[c0 + 2 * j + 1] + lnb[c0 + 2 * j + 1];
                const unsigned pk = cvt_pk_bf16(y0, y1);
                *(LAS unsigned short*)(SB + (c8 * 8 + 2 * j) * MC_LD + q * 2) = (unsigned short)(pk & 0xffffu);
                *(LAS unsigned short*)(SB + (c8 * 8 + 2 * j + 1) * MC_LD + q * 2) = (unsigned short)(pk >> 16);
            }
        }
        __syncthreads();
        f32x4 acc[4][2];
#pragma unroll
        for (int m = 0; m < 4; ++m)
#pragma unroll
            for (int nn = 0; nn < 2; ++nn) acc[m][nn] = (f32x4){0.f, 0.f, 0.f, 0.f};
#pragma unroll
        for (int ks = 0; ks < 4; ++ks) {
            bf16x8 a[4], b[2];
#pragma unroll
            for (int m = 0; m < 4; ++m) a[m] = *(const LAS bf16x8*)(SA + (wr * 64 + m * 16 + fr) * MC_LD + ks * 64 + fq * 16);
#pragma unroll
            for (int nn = 0; nn < 2; ++nn) b[nn] = *(const LAS bf16x8*)(SB + (wc * 32 + nn * 16 + fr) * MC_LD + ks * 64 + fq * 16);
#pragma unroll
            for (int m = 0; m < 4; ++m)
#pragma unroll
                for (int nn = 0; nn < 2; ++nn) acc[m][nn] = __builtin_amdgcn_mfma_f32_16x16x32_bf16(b[nn], a[m], acc[m][nn], 0, 0, 0);
        }
#pragma unroll
        for (int m = 0; m < 4; ++m) {
            const int pr = wr * 64 + m * 16 + fr; const float bias = bs[h * 128 + pr];
#pragma unroll
            for (int nn = 0; nn < 2; ++nn) {
                bf16_t* up = U + (size_t)(t0 + pr) * D + h * 128 + wc * 32 + nn * 16 + 4 * fq;
                const f32x4 uu = load4bf(up);
                store4bf(up, uu * (acc[m][nn] + bias));
            }
        }
        __syncthreads();
    }
}

struct EpiInProj {
    bf16_t *QA, *BA, *ZB, *U, *V, *G;
    __device__ __forceinline__ void pair(int r, int c0, f32x4 va, f32x4 vb) const {
        if (c0 < 2048) { store4bf(QA + (size_t)r * D + pair_col(c0), va * vb); }
        else if (c0 < 3072) { const int j = c0 - 2048; store4bf(BA + (size_t)r * D + j, va); store4bf(BA + (size_t)r * D + j + 16, vb); }
        else if (c0 < 5120) { store4bf(ZB + (size_t)r * D + pair_col(c0 - 3072), va * sig4(vb)); }
        else if (c0 < 7168) { const int cc = c0 - 5120; bf16_t* dst = (cc < 1024 ? U + cc : V + (cc - 1024)) + (size_t)r * D; store4bf(dst, gelu4(va)); store4bf(dst + 16, gelu4(vb)); }
        else { const int cc = c0 - 7168; store4bf(G + (size_t)r * (3 * D) + cc, sig4(va)); store4bf(G + (size_t)r * (3 * D) + cc + 16, sig4(vb)); }
    }
};
template <int I> struct EpiBranch {
    const bf16_t* G; float* MB; bf16_t* MG;
    __device__ __forceinline__ void one(int r, int c, f32x4 v) const {
        f32x4 m = load4bf(G + (size_t)r * (3 * D) + I * D + c) * v;
        if (I > 0) m += *(const f32x4*)(MB + (size_t)r * D + c);
        if (I < 2) *(f32x4*)(MB + (size_t)r * D + c) = m; else store4bf(MG + (size_t)r * D + c, m);
    }
    __device__ __forceinline__ void pair(int r, int c0, f32x4 va, f32x4 vb) const { one(r, c0, va); one(r, c0 + 16, vb); }
};
struct EpiWo {
    const float* xin; float* xout;
    __device__ __forceinline__ void pair(int r, int c0, f32x4 va, f32x4 vb) const {
        const size_t o = (size_t)r * D + c0;
        *(f32x4*)(xout + o) = *(const f32x4*)(xin + o) + va; *(f32x4*)(xout + o + 16) = *(const f32x4*)(xin + o + 16) + vb;
    }
};

__device__ __forceinline__ bool moe_tile(const unsigned* cnt, int ti, int TM, int& e, int& i, int& prow, int& ne) {
    int acc = 0;
    for (int x = 0; x < NE; ++x) { const int n = (int)ld_agent(cnt + x), nt = (n + TM - 1) / TM; if (ti < acc + nt) { e = x; i = ti - acc; prow = acc * TM; ne = n; return true; } acc += nt; }
    return false;
}

template <class Epi> struct ProbDense {
    const bf16_t* A; const bf16_t* Bt; int K, ntn; Epi E;
    __device__ __forceinline__ bool tile(int bid, int& bcol, const bf16_t*& Btp) { pm = bid / ntn; bcol = (bid % ntn) * 128; Btp = Bt; return true; }
    __device__ __forceinline__ const bf16_t* arow(int rl) const { return A + (size_t)(pm * 128 + rl) * K; }
    __device__ __forceinline__ void pair(int rl, int c0, f32x4 va, f32x4 vb) const { E.pair(pm * 128 + rl, c0, va, vb); }
    int pm, pad_;
};
struct ProbMoe1 {
    const bf16_t* H2; const bf16_t* W13; const unsigned* cnt; const int* slot_tok; bf16_t* ACT; int K;
    int e, i, prow, ne, pad0_, pad1_;
    __device__ __forceinline__ bool tile(int bid, int& bcol, const bf16_t*& Btp) { if (!moe_tile(cnt, bid >> 3, 128, e, i, prow, ne)) return false; prow += i * 128; bcol = (bid & 7) * 128; Btp = W13 + (size_t)e * 1024 * 1024; return true; }
    __device__ __forceinline__ const bf16_t* arow(int rl) const { const int idx = i * 128 + rl; const int tok = idx < ne ? slot_tok[e * CAP + idx] : T; return H2 + (size_t)tok * D; }
    __device__ __forceinline__ void pair(int rl, int c0, f32x4 va, f32x4 vb) const { store4bf(ACT + (size_t)(prow + rl) * DFF + pair_col(c0), silu4(va) * vb); }
};
struct ProbMoe2 {
    const bf16_t* ACT; const bf16_t* W2; const unsigned* cnt; const float* slot_w; const int* slot_asg; bf16_t* YC; int K;
    int e, i, prow, ne, pad0_;
    __device__ __forceinline__ bool tile(int bid, int& bcol, const bf16_t*& Btp) { if (!moe_tile(cnt, bid >> 3, 128, e, i, prow, ne)) return false; prow += i * 128; bcol = (bid & 7) * 128; Btp = W2 + (size_t)e * 1024 * 512; return true; }
    __device__ __forceinline__ const bf16_t* arow(int rl) const { return ACT + (size_t)(prow + rl) * DFF; }
    __device__ __forceinline__ void pair(int rl, int c0, f32x4 va, f32x4 vb) const {
        const int idx = i * 128 + rl; if (idx >= ne) return;
        const float w = slot_w[e * CAP + idx]; const int a = slot_asg[e * CAP + idx];
        store4bf(YC + (size_t)a * D + c0, va * w); store4bf(YC + (size_t)a * D + c0 + 16, vb * w);
    }
};
template <class Prob> __global__ void __launch_bounds__(256, 2) k_gemm128(Prob P) {
    __shared__ __attribute__((aligned(16))) unsigned char shm[16384];
    LAS unsigned char* SA = (LAS unsigned char*)shm; LAS unsigned char* SB = SA + 8192;
    int bcol; const bf16_t* Btp;
    if (!P.tile(blockIdx.x, bcol, Btp)) return;
    const int K = P.K, tid = threadIdx.x, wid = tid >> 6, lane = tid & 63, wr = wid >> 1, wc = wid & 1, fr = lane & 15, fq = lane >> 4;
    const bf16_t* ap[2]; const bf16_t* bp[2];
#pragma unroll
    for (int i = 0; i < 2; ++i) { const int b = tid * 16 + i * 4096, r = b >> 6, c = (b & 63) >> 1; ap[i] = P.arow(r) + c; bp[i] = Btp + (size_t)(bcol + r) * K + c; }
    f32x4 acc[4][4];
#pragma unroll
    for (int m = 0; m < 4; ++m)
#pragma unroll
        for (int n = 0; n < 4; ++n) acc[m][n] = (f32x4){0.f, 0.f, 0.f, 0.f};
    const unsigned ldsw = (unsigned)__builtin_amdgcn_readfirstlane(wid) * 1024u;
    for (int t = 0; t < K / 32; ++t) {
#pragma unroll
        for (int i = 0; i < 2; ++i) {
            __builtin_amdgcn_global_load_lds((const unsigned*)(ap[i] + t * 32), (LAS unsigned*)(SA + ldsw + i * 4096), 16, 0, 0);
            __builtin_amdgcn_global_load_lds((const unsigned*)(bp[i] + t * 32), (LAS unsigned*)(SB + ldsw + i * 4096), 16, 0, 0);
        }
        asm volatile("s_waitcnt vmcnt(0)" ::: "memory"); __syncthreads();
        bf16x8 At[4], Bf[4];
#pragma unroll
        for (int m = 0; m < 4; ++m) { At[m] = *(const LAS bf16x8*)(SA + (wr * 64 + m * 16 + fr) * 64 + fq * 16); Bf[m] = *(const LAS bf16x8*)(SB + (wc * 64 + m * 16 + fr) * 64 + fq * 16); }
        asm volatile("s_waitcnt lgkmcnt(0)" ::: "memory"); __builtin_amdgcn_sched_barrier(0);
#pragma unroll
        for (int m = 0; m < 4; ++m)
#pragma unroll
            for (int n = 0; n < 4; ++n) acc[m][n] = __builtin_amdgcn_mfma_f32_16x16x32_bf16(Bf[n], At[m], acc[m][n], 0, 0, 0);
        __syncthreads();
    }
#pragma unroll
    for (int m = 0; m < 4; ++m)
#pragma unroll
        for (int np = 0; np < 2; ++np) P.pair(wr * 64 + m * 16 + fr, bcol + wc * 64 + np * 32 + 4 * fq, acc[m][2 * np], acc[m][2 * np + 1]);
}

__global__ void __launch_bounds__(512) k_norm1(Params p) {
    const int l = p.layer;
    if (l == 0) norm_phase<false, false>(p.in[0], nullptr, nullptr, p.in[1], WSP(bf16_t, WS_H), nullptr, blockIdx.x, gridDim.x);
    else norm_phase<true, false>(p.out, p.out, WSP(bf16_t, WS_YC), p.in[1] + l * D, WSP(bf16_t, WS_H), nullptr, blockIdx.x, gridDim.x);
}
__global__ void __launch_bounds__(512) k_final(Params p) { norm_phase<true, true>(p.out, nullptr, WSP(bf16_t, WS_YC), p.in[23], nullptr, p.out, blockIdx.x, gridDim.x); }
__global__ void __launch_bounds__(512) k_router(Params p) {
    const int l = p.layer;
    router_phase(p.out, p.in[15] + l * D, p.in[16] + (size_t)l * D * NG, p.in[17] + l * NG, p.in[18] + (size_t)l * D * NE, p.in[19] + l * NE,
                 WSP(bf16_t, WS_H), WSP(unsigned, WS_CTL) + CW_CNT + 64 * l, WSP(int, WS_STOK), WSP(float, WS_SW), WSP(int, WS_SASG), blockIdx.x, gridDim.x);
}
__global__ void __launch_bounds__(512) k_midA(Params p) { midA_phase(WSP(bf16_t, WS_QA), WSP(bf16_t, WS_BA), p.in[3] + (size_t)p.layer * 3 * D, blockIdx.x, gridDim.x); }
__global__ void __launch_bounds__(512) k_midB1(Params p) { midB_conv_phase(WSP(bf16_t, WS_ZB), WSP(bf16_t, WS_CB), p.in[5] + (size_t)p.layer * 31 * D, blockIdx.x, gridDim.x); }
__global__ void __launch_bounds__(512) k_midB2(Params p) { midB_ln_phase(WSP(bf16_t, WS_CB), p.in[6] + p.layer * D, p.in[7] + p.layer * D, blockIdx.x, gridDim.x); }
__global__ void __launch_bounds__(512) k_midC1(Params p) { midC_stats_phase(WSP(bf16_t, WS_V), WSP(float, WS_STAT), blockIdx.x, gridDim.x); }
__global__ void __launch_bounds__(512) k_midC2(Params p) {
    extern __shared__ __attribute__((aligned(16))) unsigned char dsm[];
    const int l = p.layer;
    midC_gate_phase(WSP(bf16_t, WS_V), WSP(bf16_t, WS_U), WSP(float, WS_STAT), p.in[9] + l * D, p.in[10] + l * D, p.in[11] + (size_t)l * NHC * 128 * 128, p.in[12] + l * NHC * 128,
                    (LAS unsigned char*)dsm, blockIdx.x, gridDim.x);
}

static void build_cvt(CvtTable& tb, void* const* d_in, unsigned char* ws, int l) {
    const float* w_in = (const float*)d_in[2] + (size_t)l * D * DIN;
    auto set = [&](int i, const float* A, const float* B, bf16_t* dst, int ld, int K, int ndst, int pair, int cA, int cB, int batch, long sb, long db) {
        CvtDesc& c = tb.d[i]; c.A = A; c.B = B; c.dst = dst; c.ld = ld; c.K = K; c.ndst = ndst; c.pair = pair; c.colA0 = cA; c.colB0 = cB; c.batch = batch; c.sbatch = sb; c.dbatch = db;
        c.items = batch * (ndst / 64) * (K / 64); };
    bf16_t* win = (bf16_t*)(ws + WS_WIN);
    set(0, w_in, w_in, win, DIN, D, 2048, 1, 0, 2048, 1, 0, 0);
    set(1, w_in, nullptr, win + (size_t)2048 * D, DIN, D, 1024, 0, 1024, 0, 1, 0, 0);
    set(2, w_in, w_in, win + (size_t)3072 * D, DIN, D, 2048, 1, 3072, 4096, 1, 0, 0);
    set(3, w_in, nullptr, win + (size_t)5120 * D, DIN, D, 2048, 0, 5120, 0, 1, 0, 0);
    set(4, w_in, nullptr, win + (size_t)7168 * D, DIN, D, 3072, 0, 7168, 0, 1, 0, 0);
    set(5, (const float*)d_in[4] + (size_t)l * D * D, nullptr, (bf16_t*)(ws + WS_WA), D, D, D, 0, 0, 0, 1, 0, 0);
    set(6, (const float*)d_in[8] + (size_t)l * D * D, nullptr, (bf16_t*)(ws + WS_WB), D, D, D, 0, 0, 0, 1, 0, 0);
    set(7, (const float*)d_in[13] + (size_t)l * D * D, nullptr, (bf16_t*)(ws + WS_WC), D, D, D, 0, 0, 0, 1, 0, 0);
    set(8, (const float*)d_in[14] + (size_t)l * D * D, nullptr, (bf16_t*)(ws + WS_WO), D, D, D, 0, 0, 0, 1, 0, 0);
    set(9, (const float*)d_in[20] + (size_t)l * NE * D * DFF, (const float*)d_in[21] + (size_t)l * NE * D * DFF, (bf16_t*)(ws + WS_W13), DFF, D, 1024, 1, 0, 0, NE, (long)D * DFF, (long)1024 * D);
    set(10, (const float*)d_in[22] + (size_t)l * NE * DFF * D, nullptr, (bf16_t*)(ws + WS_W2), D, DFF, D, 0, 0, 0, NE, (long)DFF * D, (long)D * DFF);
    tb.total = 0; for (int i = 0; i < NCVT; ++i) tb.total += tb.d[i].items; tb.pad = 0;
}

extern "C" void kernel_launch(void* const* d_in, const int* in_sizes, int n_in, void* d_out, int out_size, void* d_ws, size_t ws_size, hipStream_t stream) {
    if (n_in != 24 || ws_size < WS_END) { fprintf(stderr, "kernel_launch: unexpected n_in %d or ws_size %zu < %zu\n", n_in, ws_size, (size_t)WS_END); return; }
    static bool attr = false;
    if (!attr) { hipFuncSetAttribute((const void*)k_midC2, hipFuncAttributeMaxDynamicSharedMemorySize, MC_LDS_BYTES); attr = true; }
    unsigned char* ws = (unsigned char*)d_ws;
    hipMemsetAsync(ws + WS_CTL, 0, 4096, stream);
    Params p{}; for (int i = 0; i < 24; ++i) p.in[i] = (const float*)d_in[i]; p.out = (float*)d_out; p.ws = ws;
    const int G = 1024;
    for (int l = 0; l < NL; ++l) {
        p.layer = l;
        CvtTable tb{}; build_cvt(tb, d_in, ws, l);
        hipLaunchKernelGGL(k_cvt, dim3(2048), dim3(512), 0, stream, tb);
        hipLaunchKernelGGL(k_norm1, dim3(G), dim3(512), 0, stream, p);
        {
            ProbDense<EpiInProj> P{}; P.A = (const bf16_t*)(ws + WS_H); P.Bt = (const bf16_t*)(ws + WS_WIN); P.K = D; P.ntn = DIN / 128;
            P.E = EpiInProj{(bf16_t*)(ws + WS_QA), (bf16_t*)(ws + WS_BA), (bf16_t*)(ws + WS_ZB), (bf16_t*)(ws + WS_U), (bf16_t*)(ws + WS_V), (bf16_t*)(ws + WS_G)};
            hipLaunchKernelGGL(k_gemm128<ProbDense<EpiInProj>>, dim3((T / 128) * (DIN / 128)), dim3(256), 0, stream, P);
        }
        hipLaunchKernelGGL(k_midA, dim3(G), dim3(512), 0, stream, p);
        hipLaunchKernelGGL(k_midB1, dim3(G), dim3(512), 0, stream, p);
        hipLaunchKernelGGL(k_midB2, dim3(G), dim3(512), 0, stream, p);
        hipLaunchKernelGGL(k_midC1, dim3(G), dim3(512), 0, stream, p);
        hipLaunchKernelGGL(k_midC2, dim3(1024), dim3(512), MC_LDS_BYTES, stream, p);
        {
            ProbDense<EpiBranch<0>> P0{}; P0.A = (const bf16_t*)(ws + WS_BA); P0.Bt = (const bf16_t*)(ws + WS_WA); P0.K = D; P0.ntn = D / 128;
            P0.E = EpiBranch<0>{(const bf16_t*)(ws + WS_G), (float*)(ws + WS_MB), (bf16_t*)(ws + WS_H)};
            hipLaunchKernelGGL(k_gemm128<ProbDense<EpiBranch<0>>>, dim3((T / 128) * (D / 128)), dim3(256), 0, stream, P0);
            ProbDense<EpiBranch<1>> P1{}; P1.A = (const bf16_t*)(ws + WS_CB); P1.Bt = (const bf16_t*)(ws + WS_WB); P1.K = D; P1.ntn = D / 128;
            P1.E = EpiBranch<1>{(const bf16_t*)(ws + WS_G), (float*)(ws + WS_MB), (bf16_t*)(ws + WS_H)};
            hipLaunchKernelGGL(k_gemm128<ProbDense<EpiBranch<1>>>, dim3((T / 128) * (D / 128)), dim3(256), 0, stream, P1);
            ProbDense<EpiBranch<2>> P2{}; P2.A = (const bf16_t*)(ws + WS_U); P2.Bt = (const bf16_t*)(ws + WS_WC); P2.K = D; P2.ntn = D / 128;
            P2.E = EpiBranch<2>{(const bf16_t*)(ws + WS_G), (float*)(ws + WS_MB), (bf16_t*)(ws + WS_H)};
            hipLaunchKernelGGL(k_gemm128<ProbDense<EpiBranch<2>>>, dim3((T / 128) * (D / 128)), dim3(256), 0, stream, P2);
        }
        {
            ProbDense<EpiWo> P{}; P.A = (const bf16_t*)(ws + WS_H); P.Bt = (const bf16_t*)(ws + WS_WO); P.K = D; P.ntn = D / 128;
            P.E = EpiWo{l == 0 ? (const float*)d_in[0] : (const float*)d_out, (float*)d_out};
            hipLaunchKernelGGL(k_gemm128<ProbDense<EpiWo>>, dim3((T / 128) * (D / 128)), dim3(256), 0, stream, P);
        }
        hipLaunchKernelGGL(k_router, dim3(G), dim3(512), 0, stream, p);
        {
            const unsigned* cnt = (const unsigned*)(ws + WS_CTL) + CW_CNT + 64 * l;
            ProbMoe1 M1{}; M1.H2 = (const bf16_t*)(ws + WS_H); M1.W13 = (const bf16_t*)(ws + WS_W13); M1.cnt = cnt; M1.slot_tok = (const int*)(ws + WS_STOK); M1.ACT = (bf16_t*)(ws + WS_ACT); M1.K = D;
            hipLaunchKernelGGL(k_gemm128<ProbMoe1>, dim3((2 * T / 128 + NE) * 8), dim3(256), 0, stream, M1);
            ProbMoe2 M2{}; M2.ACT = (const bf16_t*)(ws + WS_ACT); M2.W2 = (const bf16_t*)(ws + WS_W2); M2.cnt = cnt; M2.slot_w = (const float*)(ws + WS_SW); M2.slot_asg = (const int*)(ws + WS_SASG); M2.YC = (bf16_t*)(ws + WS_YC); M2.K = DFF;
            hipLaunchKernelGGL(k_gemm128<ProbMoe2>, dim3((2 * T / 128 + NE) * 8), dim3(256), 0, stream, M2);
        }
    }
    hipLaunchKernelGGL(k_final, dim3(G), dim3(512), 0, stream, p);
}
```

```cpp
#include <hip/hip_runtime.h>
#include <stdint.h>
#include <stdio.h>

#define LAS __attribute__((address_space(3)))
#define CAS __attribute__((address_space(4)))
typedef unsigned short bf16_t;
typedef short bf16x8 __attribute__((ext_vector_type(8)));
typedef float f32x4 __attribute__((ext_vector_type(4)));
typedef float f32x2 __attribute__((ext_vector_type(2)));
typedef unsigned u32x4 __attribute__((ext_vector_type(4)));
typedef unsigned u32x2 __attribute__((ext_vector_type(2)));

constexpr int T = 16384, D = 1024, SEQ = 8192, DIN = 10240, NE = 32, NG = 4, EPG = 8, DFF = 512, NHC = 8;
constexpr int CAP = 16384;
constexpr int NL = 2;
constexpr float RMS_EPS = 1e-6f, LN_EPS = 1e-5f;

constexpr size_t MiB = 1u << 20;
constexpr size_t WS_CTL = 0, CTL_BYTES = 32768;
constexpr size_t WS_WIN = 2 * MiB, WS_WA = 22 * MiB, WS_WB = 24 * MiB, WS_WC = 26 * MiB, WS_WO = 28 * MiB, WS_W13 = 30 * MiB, WS_W2 = 94 * MiB;
constexpr size_t WS_H = 126 * MiB;
constexpr size_t WS_QA = 159 * MiB, WS_BA = 191 * MiB, WS_U = 255 * MiB, WS_V = 287 * MiB, WS_G = 319 * MiB;
constexpr size_t WS_ZB = 447 * MiB;
constexpr int ZPAD = 15, ZSEQ = SEQ + 2 * ZPAD;
constexpr size_t WS_CB = 223 * MiB;
constexpr size_t WS_ACT = WS_QA;
constexpr size_t WS_YC = 223 * MiB;
constexpr size_t WS_STOK = 511 * MiB, WS_SW = 513 * MiB, WS_SASG = 515 * MiB;
constexpr size_t WS_STAT = 517 * MiB;
constexpr size_t WS_END = 518 * MiB;
constexpr int CW_CNT = 0;
constexpr int CW_BAR = 1024;

__device__ __forceinline__ unsigned cvt_pk_bf16(float lo, float hi) { unsigned r; asm volatile("v_cvt_pk_bf16_f32 %0, %1, %2" : "=v"(r) : "v"(lo), "v"(hi)); return r; }
__device__ __forceinline__ float bf_lo(unsigned p) { return __uint_as_float(p << 16); }
__device__ __forceinline__ float bf_hi(unsigned p) { return __uint_as_float(p & 0xffff0000u); }
__device__ __forceinline__ float wave_sum(float v) {
#pragma unroll
    for (int o = 1; o < 64; o <<= 1) v += __shfl_xor(v, o);
    return v;
}
__device__ __forceinline__ float sigmoidf_(float x) { return __builtin_amdgcn_rcpf(1.0f + __expf(-x)); }
__device__ __forceinline__ float siluf_(float x) { return x * sigmoidf_(x); }
__device__ __forceinline__ float gelu_tanh_(float x) { const float z = 0.7978845608028654f * (x + 0.044715f * x * x * x); return x * sigmoidf_(2.0f * z); }
__device__ __forceinline__ f32x4 sig4(f32x4 v) { return (f32x4){sigmoidf_(v[0]), sigmoidf_(v[1]), sigmoidf_(v[2]), sigmoidf_(v[3])}; }
__device__ __forceinline__ f32x4 silu4(f32x4 v) { return (f32x4){siluf_(v[0]), siluf_(v[1]), siluf_(v[2]), siluf_(v[3])}; }
__device__ __forceinline__ f32x4 gelu4(f32x4 v) { return (f32x4){gelu_tanh_(v[0]), gelu_tanh_(v[1]), gelu_tanh_(v[2]), gelu_tanh_(v[3])}; }
__device__ __forceinline__ void store4bf(bf16_t* p, f32x4 v) { u32x2 w; w.x = cvt_pk_bf16(v[0], v[1]); w.y = cvt_pk_bf16(v[2], v[3]); *(u32x2*)p = w; }
__device__ __forceinline__ f32x4 load4bf(const bf16_t* p) { const u32x2 w = *(const u32x2*)p; return (f32x4){bf_lo(w.x), bf_hi(w.x), bf_lo(w.y), bf_hi(w.y)}; }
__device__ __forceinline__ unsigned ld_agent(const unsigned* p) { return __hip_atomic_load(p, __ATOMIC_RELAXED, __HIP_MEMORY_SCOPE_AGENT); }

typedef __amdgpu_buffer_rsrc_t rsrc_t;
__device__ __forceinline__ rsrc_t mkrsrc(const void* p, unsigned bytes) { return __builtin_amdgcn_make_buffer_rsrc(const_cast<void*>(p), (short)0, (int)bytes, 0x00020000); }
__device__ __forceinline__ f32x4 bld4bf(rsrc_t r, unsigned voff, unsigned soff) { const u32x2 w = __builtin_amdgcn_raw_buffer_load_b64(r, voff, soff, 0); return (f32x4){bf_lo(w.x), bf_hi(w.x), bf_lo(w.y), bf_hi(w.y)}; }
__device__ __forceinline__ void bst4bf(rsrc_t r, unsigned voff, unsigned soff, f32x4 v) { u32x2 w; w.x = cvt_pk_bf16(v[0], v[1]); w.y = cvt_pk_bf16(v[2], v[3]); __builtin_amdgcn_raw_buffer_store_b64(w, r, voff, soff, 0); }
__device__ __forceinline__ f32x4 bld4f(rsrc_t r, unsigned voff, unsigned soff) { const u32x4 w = __builtin_amdgcn_raw_buffer_load_b128(r, voff, soff, 0); return (f32x4){__uint_as_float(w.x), __uint_as_float(w.y), __uint_as_float(w.z), __uint_as_float(w.w)}; }
__device__ __forceinline__ void bst4f(rsrc_t r, unsigned voff, unsigned soff, f32x4 v) { u32x4 w; w.x = __float_as_uint(v[0]); w.y = __float_as_uint(v[1]); w.z = __float_as_uint(v[2]); w.w = __float_as_uint(v[3]); __builtin_amdgcn_raw_buffer_store_b128(w, r, voff, soff, 0); }
__device__ __forceinline__ int pair_col(int c) { return 32 * (c >> 6) + 16 * ((c >> 5) & 1) + (c & 15); }

struct CvtDesc { const float* A; const float* B; bf16_t* dst; long sbatch, dbatch; int ld, K, ndst, pair, colA0, colB0, batch, items; };
constexpr int NCVT = 11;
struct CvtTable { CvtDesc d[NCVT]; int total, pad; };

__device__ __forceinline__ void cvt_item(const CvtDesc& c, int item, LAS float* tile  , int tid, int nthr) {
    const int ntn = c.ndst / 64, ntk = c.K / 64;
    const int b = item / (ntn * ntk), rem = item % (ntn * ntk), nb = rem / ntk, kb = rem % ntk, n0 = nb * 64, k0 = kb * 64;
    const float* A = c.A + (size_t)b * c.sbatch; const float* B = c.B ? c.B + (size_t)b * c.sbatch : nullptr; bf16_t* dst = c.dst + (size_t)b * c.dbatch;
    for (int idx = tid; idx < 4096; idx += nthr) {
        const int kk = idx >> 6, nl = idx & 63; const float* src; int col;
        if (c.pair) { const int sub = nl >> 4, i = nl & 15; src = (sub & 1) ? B : A; col = ((sub & 1) ? c.colB0 : c.colA0) + 32 * nb + 16 * (sub >> 1) + i; }
        else { src = A; col = c.colA0 + n0 + nl; }
        tile[kk * 65 + nl] = src[(size_t)(k0 + kk) * c.ld + col];
    }
    __syncthreads();
    for (int idx = tid; idx < 512; idx += nthr) {
        const int nl = idx >> 3, ch = idx & 7; const LAS float* s = tile + (8 * ch) * 65 + nl;
        u32x4 o; o.x = cvt_pk_bf16(s[0], s[65]); o.y = cvt_pk_bf16(s[2 * 65], s[3 * 65]); o.z = cvt_pk_bf16(s[4 * 65], s[5 * 65]); o.w = cvt_pk_bf16(s[6 * 65], s[7 * 65]);
        *(u32x4*)(dst + (size_t)(n0 + nl) * c.K + k0 + 8 * ch) = o;
    }
    __syncthreads();
}
__device__ __forceinline__ void cvt_phase(const CAS CvtTable* tb, LAS float* tile, int tid, int bid, int nblk) {
    const int total = tb->total;
    for (int it = bid; it < total; it += nblk) {
        int r = it, di = 0;
        while (di < NCVT - 1 && r >= tb->d[di].items) { r -= tb->d[di].items; ++di; }
        CvtDesc c; c.A = tb->d[di].A; c.B = tb->d[di].B; c.dst = tb->d[di].dst; c.sbatch = tb->d[di].sbatch; c.dbatch = tb->d[di].dbatch; c.ld = tb->d[di].ld; c.K = tb->d[di].K; c.ndst = tb->d[di].ndst;
        c.pair = tb->d[di].pair; c.colA0 = tb->d[di].colA0; c.colB0 = tb->d[di].colB0; c.batch = tb->d[di].batch; c.items = tb->d[di].items;
        cvt_item(c, r, tile, tid, 512);
    }
}

template <bool COMBINE, bool FINAL>
__device__ __forceinline__ void norm_phase(const float* xsrc, float* xbuf, const bf16_t* yc, const float* g, bf16_t* h, float* outf, int tid, int bid, int nblk) {
    const int lane = tid & 63, wave = tid >> 6, nw = 8;
    f32x4 gv[4];
#pragma unroll
    for (int j = 0; j < 4; ++j) gv[j] = *(const f32x4*)(g + 4 * lane + 256 * j);
    for (int row = bid * nw + wave; row < T; row += nblk * nw) {
        f32x4 v[4]; float ss = 0.f;
#pragma unroll
        for (int j = 0; j < 4; ++j) {
            v[j] = *(const f32x4*)(xsrc + (size_t)row * D + 4 * lane + 256 * j);
            if (COMBINE) { v[j] += load4bf(yc + (size_t)(2 * row) * D + 4 * lane + 256 * j); v[j] += load4bf(yc + (size_t)(2 * row + 1) * D + 4 * lane + 256 * j); }
            ss += (v[j][0] * v[j][0] + v[j][1] * v[j][1]) + (v[j][2] * v[j][2] + v[j][3] * v[j][3]);
        }
        const float rstd = rsqrtf(wave_sum(ss) * (1.0f / D) + RMS_EPS);
#pragma unroll
        for (int j = 0; j < 4; ++j) {
            if (COMBINE && !FINAL) *(f32x4*)(xbuf + (size_t)row * D + 4 * lane + 256 * j) = v[j];
            const f32x4 o = v[j] * rstd * gv[j];
            if (FINAL) *(f32x4*)(outf + (size_t)row * D + 4 * lane + 256 * j) = o;
            else store4bf(h + (size_t)row * D + 4 * lane + 256 * j, o);
        }
    }
}

constexpr int RING_BYTES = 131072;
constexpr int LDSCTL_OFF = RING_BYTES, MISC_OFF = LDSCTL_OFF + 320;
constexpr int MOE_OFF = LDSCTL_OFF + 1024;
constexpr int RT_LOG = LDSCTL_OFF + 2048;
constexpr int RT_HIST = RT_LOG + 64 * 40 * 4;
constexpr int LDS_BYTES = 147456;
static_assert(RT_HIST + 256 <= LDS_BYTES, "LDS map");
__device__ __forceinline__ void router_phase(const float* xbuf, const float* g, const float* wg, const float* bg, const float* wr, const float* br,
                                             bf16_t* h2, unsigned* cnt, int* slot_tok, float* slot_w, int* slot_asg, LAS unsigned char* lds, int tid, int bid, int nblk) {
    const int lane = tid & 63, wid = tid >> 6, kk = lane & 15, rg = lane >> 4;
    if (bid == 0) for (int i = tid; i < D / 2; i += 512) ((unsigned*)(h2 + (size_t)T * D))[i] = 0u;
    for (int idx = tid; idx < 8192; idx += 512) {
        const int k = idx >> 3, q = idx & 7, kk_ = (k & 63) >> 2, e = k & 3, c = k >> 6;
        *(LAS f32x4*)(lds + q * 16384 + c * 1024 + e * 256 + kk_ * 16) = *(const f32x4*)(wr + (size_t)k * NE + 4 * q);
    }
    LAS float* logit = (LAS float*)(lds + RT_LOG); LAS int* hist = (LAS int*)(lds + RT_HIST); LAS int* base = hist + 32;
    __syncthreads();
    for (int rb = bid; rb < T / 64; rb += nblk) {
        const int rl0 = wid * 8 + rg, row0 = rb * 64 + rl0;
        const float* x0 = xbuf + (size_t)row0 * D + 4 * kk; const float* x1 = x0 + 4 * D;
        float a0[36], a1[36];
#pragma unroll
        for (int i = 0; i < 36; ++i) { a0[i] = 0.f; a1[i] = 0.f; }
        float ss0 = 0.f, ss1 = 0.f;
        f32x4 nxa = *(const f32x4*)x0, nxb = *(const f32x4*)x1, ngg = *(const f32x4*)(g + 4 * kk);
        f32x4 nwg[4];
#pragma unroll
        for (int e = 0; e < 4; ++e) nwg[e] = *(const f32x4*)(wg + (size_t)(4 * kk + e) * NG);
#pragma unroll 1
        for (int c = 0; c < 16; ++c) {
            f32x4 xa = nxa, xb = nxb; const f32x4 gg = ngg; f32x4 wgv[4];
#pragma unroll
            for (int e = 0; e < 4; ++e) wgv[e] = nwg[e];
            const int cn = c < 15 ? c + 1 : c;
            nxa = *(const f32x4*)(x0 + 64 * cn); nxb = *(const f32x4*)(x1 + 64 * cn); ngg = *(const f32x4*)(g + 4 * kk + 64 * cn);
#pragma unroll
            for (int e = 0; e < 4; ++e) nwg[e] = *(const f32x4*)(wg + (size_t)(4 * kk + e + 64 * cn) * NG);
            ss0 += (xa[0] * xa[0] + xa[1] * xa[1]) + (xa[2] * xa[2] + xa[3] * xa[3]);
            ss1 += (xb[0] * xb[0] + xb[1] * xb[1]) + (xb[2] * xb[2] + xb[3] * xb[3]);
            xa *= gg; xb *= gg;
            const LAS unsigned char* wl = lds + c * 1024 + kk * 16;
#pragma unroll
            for (int e = 0; e < 4; ++e) {
#pragma unroll
                for (int i = 0; i < 4; ++i) { a0[i] += xa[e] * wgv[e][i]; a1[i] += xb[e] * wgv[e][i]; }
#pragma unroll
                for (int q = 0; q < 8; ++q) { const f32x4 wv = *(const LAS f32x4*)(wl + q * 16384 + e * 256);
#pragma unroll
                    for (int i = 0; i < 4; ++i) { a0[4 + 4 * q + i] += xa[e] * wv[i]; a1[4 + 4 * q + i] += xb[e] * wv[i]; } }
            }
        }
#pragma unroll
        for (int o = 1; o < 16; o <<= 1) {
            ss0 += __shfl_xor(ss0, o); ss1 += __shfl_xor(ss1, o);
#pragma unroll
            for (int i = 0; i < 36; ++i) { a0[i] += __shfl_xor(a0[i], o); a1[i] += __shfl_xor(a1[i], o); }
        }
        const float rstd0 = rsqrtf(ss0 * (1.0f / D) + RMS_EPS), rstd1 = rsqrtf(ss1 * (1.0f / D) + RMS_EPS);
        if (kk == 0) {
#pragma unroll
            for (int i = 0; i < 36; ++i) { const float b = i < 4 ? bg[i] : br[i - 4]; logit[rl0 * 40 + i] = a0[i] * rstd0 + b; logit[(rl0 + 4) * 40 + i] = a1[i] * rstd1 + b; }
        }
#pragma unroll
        for (int cb = 0; cb < 16; cb += 4) {
            f32x4 xa[4], xb[4], gg[4];
#pragma unroll
            for (int j = 0; j < 4; ++j) { xa[j] = *(const f32x4*)(x0 + 64 * (cb + j)); xb[j] = *(const f32x4*)(x1 + 64 * (cb + j)); gg[j] = *(const f32x4*)(g + 4 * kk + 64 * (cb + j)); }
#pragma unroll
            for (int j = 0; j < 4; ++j) { store4bf(h2 + (size_t)row0 * D + 4 * kk + 64 * (cb + j), xa[j] * gg[j] * rstd0); store4bf(h2 + (size_t)(row0 + 4) * D + 4 * kk + 64 * (cb + j), xb[j] * gg[j] * rstd1); }
        }
        if (tid < 32) hist[tid] = 0;
        asm volatile("s_waitcnt lgkmcnt(0)" ::: "memory"); __syncthreads();
        int e0 = 0, e1 = 0, lr0 = 0, lr1 = 0; float w0 = 0.f, w1 = 0.f;
        if (tid < 64) {
            const LAS float* lp = logit + tid * 40;
            int gi = 0; float gm = lp[0];
#pragma unroll
            for (int i = 1; i < NG; ++i) { const float v = lp[i]; if (v > gm) { gm = v; gi = i; } }
            float gs = 0.f;
#pragma unroll
            for (int i = 0; i < NG; ++i) gs += __expf(lp[i] - gm);
            const float gp = 1.0f / gs;
            const LAS float* ep = lp + 4 + gi * EPG;
            int i0 = 0; float m0 = ep[0];
#pragma unroll
            for (int i = 1; i < EPG; ++i) { const float v = ep[i]; if (v > m0) { m0 = v; i0 = i; } }
            int i1 = -1; float m1 = -3.0e38f;
#pragma unroll
            for (int i = 0; i < EPG; ++i) { const float v = ep[i]; if (i != i0 && v > m1) { m1 = v; i1 = i; } }
            const float ex = __expf(m1 - m0); w0 = gp / (1.0f + ex); w1 = gp * ex / (1.0f + ex);
            e0 = gi * EPG + i0; e1 = gi * EPG + i1;
            lr0 = __hip_atomic_fetch_add((int*)(hist + e0), 1, __ATOMIC_RELAXED, __HIP_MEMORY_SCOPE_WORKGROUP);
            lr1 = __hip_atomic_fetch_add((int*)(hist + e1), 1, __ATOMIC_RELAXED, __HIP_MEMORY_SCOPE_WORKGROUP);
        }
        asm volatile("s_waitcnt lgkmcnt(0)" ::: "memory"); __syncthreads();
        if (tid < 32) { const int n = hist[tid]; base[tid] = n > 0 ? (int)atomicAdd(cnt + tid, (unsigned)n) : 0; }
        asm volatile("s_waitcnt vmcnt(0) lgkmcnt(0)" ::: "memory"); __syncthreads();
        if (tid < 64) {
            const int row = rb * 64 + tid, s0 = e0 * CAP + base[e0] + lr0, s1 = e1 * CAP + base[e1] + lr1;
            slot_tok[s0] = row; slot_w[s0] = w0; slot_asg[s0] = 2 * row;
            slot_tok[s1] = row; slot_w[s1] = w1; slot_asg[s1] = 2 * row + 1;
        }
        __syncthreads();
    }
}

__device__ __forceinline__ void midA_phase(const bf16_t* QA, bf16_t* BA, const float* cw  , int bid, int nblk) {
    const int nthr = blockDim.x;
    for (int idx = bid * nthr + threadIdx.x; idx < T * (D / 8); idx += nblk * nthr) {
        const int t = idx >> 7, c = (idx & 127) * 8, s = t & (SEQ - 1);
        const u32x4 z = {0u, 0u, 0u, 0u};
        const u32x4 q1 = *(const u32x4*)(QA + (size_t)t * D + c);
        u32x4 q0 = *(const u32x4*)(QA + (size_t)(s > 0 ? t - 1 : t) * D + c);
        u32x4 q2 = *(const u32x4*)(QA + (size_t)(s < SEQ - 1 ? t + 1 : t) * D + c);
        q0 = s > 0 ? q0 : z; q2 = s < SEQ - 1 ? q2 : z;
        const u32x4 bb = *(const u32x4*)(BA + (size_t)t * D + c);
        u32x4 o;
#pragma unroll
        for (int j = 0; j < 4; ++j) {
            const int c0 = c + 2 * j;
            const float lo = bf_lo(bb[j]) * (cw[c0] * bf_lo(q0[j]) + cw[D + c0] * bf_lo(q1[j]) + cw[2 * D + c0] * bf_lo(q2[j]));
            const float hi = bf_hi(bb[j]) * (cw[c0 + 1] * bf_hi(q0[j]) + cw[D + c0 + 1] * bf_hi(q1[j]) + cw[2 * D + c0 + 1] * bf_hi(q2[j]));
            o[j] = cvt_pk_bf16(lo, hi);
        }
        *(u32x4*)(BA + (size_t)t * D + c) = o;
    }
}
__device__ __forceinline__ void midB_conv_phase(const bf16_t* ZB, bf16_t* CB, const float* cw  , int bid, int nblk) {
    for (int cp = threadIdx.x; cp < D / 2; cp += blockDim.x) {
        f32x2 w[31];
#pragma unroll
        for (int j = 0; j < 31; ++j) w[j] = *(const f32x2*)(cw + j * D + 2 * cp);
        for (int tg = bid; tg < T / 16; tg += nblk) {
            const int t0 = tg * 16, s0 = t0 & (SEQ - 1);
            f32x2 acc[16];
#pragma unroll
            for (int o = 0; o < 16; ++o) acc[o] = (f32x2){0.f, 0.f};
#pragma unroll
            for (int i = 0; i < 46; ++i) {
                const int s = s0 - 15 + i;
                const bool ok = (s >= 0 && s < SEQ);
                unsigned xv = *(const unsigned*)(ZB + (size_t)(ok ? t0 - 15 + i : t0) * D + 2 * cp);
                xv = ok ? xv : 0u;
                const f32x2 x = {bf_lo(xv), bf_hi(xv)};
#pragma unroll
                for (int o = 0; o < 16; ++o) { const int j = i - o; if (j >= 0 && j < 31) acc[o] += w[j] * x; }
            }
#pragma unroll
            for (int o = 0; o < 16; ++o) *(unsigned*)(CB + (size_t)(t0 + o) * D + 2 * cp) = cvt_pk_bf16(acc[o][0], acc[o][1]);
        }
    }
}
__device__ __forceinline__ void row16_load(const bf16_t* rowp, int lane, float (&x)[16]) {
    const u32x4 a = *(const u32x4*)(rowp + 8 * lane), b = *(const u32x4*)(rowp + 512 + 8 * lane);
#pragma unroll
    for (int j = 0; j < 4; ++j) { x[2 * j] = bf_lo(a[j]); x[2 * j + 1] = bf_hi(a[j]); x[8 + 2 * j] = bf_lo(b[j]); x[8 + 2 * j + 1] = bf_hi(b[j]); }
}
__device__ __forceinline__ void row16_stats(const float (&x)[16], float& mean, float& rstd) {
    float s = 0.f;
#pragma unroll
    for (int j = 0; j < 16; ++j) s += x[j];
    mean = wave_sum(s) * (1.0f / D);
    float q = 0.f;
#pragma unroll
    for (int j = 0; j < 16; ++j) { const float d = x[j] - mean; q += d * d; }
    rstd = rsqrtf(wave_sum(q) * (1.0f / D) + LN_EPS);
}
__device__ __forceinline__ void midB_ln_phase(bf16_t* CB, const float* g, const float* b, int bid, int nblk) {
    const int lane = threadIdx.x & 63, wave = threadIdx.x >> 6, nw = blockDim.x >> 6;
    float gg[16], bb[16];
#pragma unroll
    for (int j = 0; j < 8; ++j) { gg[j] = g[8 * lane + j]; gg[8 + j] = g[512 + 8 * lane + j]; bb[j] = b[8 * lane + j]; bb[8 + j] = b[512 + 8 * lane + j]; }
    for (int row = bid * nw + wave; row < T; row += nblk * nw) {
        float x[16], mean, rstd; row16_load(CB + (size_t)row * D, lane, x); row16_stats(x, mean, rstd);
        u32x4 o0, o1;
#pragma unroll
        for (int j = 0; j < 4; ++j) {
            o0[j] = cvt_pk_bf16(siluf_((x[2 * j] - mean) * rstd * gg[2 * j] + bb[2 * j]), siluf_((x[2 * j + 1] - mean) * rstd * gg[2 * j + 1] + bb[2 * j + 1]));
            o1[j] = cvt_pk_bf16(siluf_((x[8 + 2 * j] - mean) * rstd * gg[8 + 2 * j] + bb[8 + 2 * j]), siluf_((x[8 + 2 * j + 1] - mean) * rstd * gg[8 + 2 * j + 1] + bb[8 + 2 * j + 1]));
        }
        *(u32x4*)(CB + (size_t)row * D + 8 * lane) = o0; *(u32x4*)(CB + (size_t)row * D + 512 + 8 * lane) = o1;
    }
}
__device__ __forceinline__ void midC_stats_phase(const bf16_t* V, float* stat, int bid, int nblk) {
    const int lane = threadIdx.x & 63, wave = threadIdx.x >> 6, nw = blockDim.x >> 6;
    for (int row = bid * nw + wave; row < T; row += nblk * nw) {
        float x[16], mean, rstd; row16_load(V + (size_t)row * D, lane, x); row16_stats(x, mean, rstd);
        if (lane == 0) *(f32x2*)(stat + 2 * row) = (f32x2){mean, rstd};
    }
}
constexpr int MC_LD = 272;
constexpr int MID_STAT = 0, MID_SA = 1024, MID_SB = 1024 + 64 * MC_LD, MID_LDS = MID_SB + 128 * MC_LD;
__device__ __forceinline__ void mid_phase(rsrc_t wsr, const bf16_t* QA, bf16_t* BA, bf16_t* CB, const bf16_t* V, bf16_t* U,
                                          const float* cwa  , const float* cwb  , const float* lnbg, const float* lnbb, const float* lncg, const float* lncb,
                                          const float* Ws  , const float* bs  , LAS unsigned char* lds, int tid, int bid, int nblk) {
    const int lane = tid & 63, wid = tid >> 6, fr = lane & 15, fq = lane >> 4;
    LAS float* statL = (LAS float*)(lds + MID_STAT); LAS unsigned char* SA = lds + MID_SA; LAS unsigned char* SB = lds + MID_SB;
    for (int tile = bid; tile < T / 64; tile += nblk) {
        const int t0 = tile * 64, ch0 = (tile >> 1) * 128, half = tile & 1;
#ifndef MIDPART
#define MIDPART 31
#endif
        if (MIDPART & 1) for (int idx = tid; idx < 64 * 128; idx += 512) {
            const int t = t0 + (idx >> 7), c = (idx & 127) * 8, s = t & (SEQ - 1);
            const u32x4 z = {0u, 0u, 0u, 0u};
            const u32x4 q1 = *(const u32x4*)(QA + (size_t)t * D + c);
            u32x4 q0 = *(const u32x4*)(QA + (size_t)(s > 0 ? t - 1 : t) * D + c);
            u32x4 q2 = *(const u32x4*)(QA + (size_t)(s < SEQ - 1 ? t + 1 : t) * D + c);
            q0 = s > 0 ? q0 : z; q2 = s < SEQ - 1 ? q2 : z;
            const u32x4 bb = *(const u32x4*)(BA + (size_t)t * D + c);
            u32x4 o;
#pragma unroll
            for (int j = 0; j < 4; ++j) {
                const int c0 = c + 2 * j;
                const float lo = bf_lo(bb[j]) * (cwa[c0] * bf_lo(q0[j]) + cwa[D + c0] * bf_lo(q1[j]) + cwa[2 * D + c0] * bf_lo(q2[j]));
                const float hi = bf_hi(bb[j]) * (cwa[c0 + 1] * bf_hi(q0[j]) + cwa[D + c0 + 1] * bf_hi(q1[j]) + cwa[2 * D + c0 + 1] * bf_hi(q2[j]));
                o[j] = cvt_pk_bf16(lo, hi);
            }
            *(u32x4*)(BA + (size_t)t * D + c) = o;
        }
        if (MIDPART & 2) {
            const int cp = tid;
            f32x2 w[31];
#pragma unroll
            for (int j = 0; j < 31; ++j) w[j] = *(const f32x2*)(cwb + j * D + 2 * cp);
            const unsigned zrow0 = (unsigned)(t0 + 2 * ZPAD * (t0 >= SEQ ? 1 : 0));
            for (int g = 0; g < 4; ++g) {
                const unsigned sb = (unsigned)WS_ZB + (zrow0 + 16u * (unsigned)g) * (unsigned)(D * 2);
                f32x2 acc[16];
#pragma unroll
                for (int o = 0; o < 16; ++o) acc[o] = (f32x2){0.f, 0.f};
#pragma unroll
                for (int ib = 0; ib < 48; ib += 8) {
                    unsigned xv[8];
#pragma unroll
                    for (int q = 0; q < 8; ++q) if (ib + q < 46) xv[q] = __builtin_amdgcn_raw_buffer_load_b32(wsr, (unsigned)(4 * cp), sb + (unsigned)((ib + q) * D * 2), 0);
#pragma unroll
                    for (int q = 0; q < 8; ++q) if (ib + q < 46) {
                        const int i = ib + q; const f32x2 x = {bf_lo(xv[q]), bf_hi(xv[q])};
#pragma unroll
                        for (int o = 0; o < 16; ++o) { const int j = i - o; if (j >= 0 && j < 31) acc[o] += w[j] * x; }
                    }
                }
                const unsigned so = (unsigned)WS_CB + (unsigned)(t0 + 16 * g) * (unsigned)(D * 2);
#pragma unroll
                for (int o = 0; o < 16; ++o) __builtin_amdgcn_raw_buffer_store_b32(cvt_pk_bf16(acc[o][0], acc[o][1]), wsr, (unsigned)(4 * cp), so + (unsigned)(o * D * 2), 0);
            }
        }
        if (MIDPART & 4) for (int r = wid; r < 128; r += 8) {
            float x[16], mean, rstd; row16_load(V + (size_t)(ch0 + r) * D, lane, x); row16_stats(x, mean, rstd);
            if (lane == 0) { statL[2 * r] = mean; statL[2 * r + 1] = rstd; }
        }
        asm volatile("s_waitcnt vmcnt(0) lgkmcnt(0)" ::: "memory"); __syncthreads();
        if (MIDPART & 8) {
            float gg[16], bb[16];
#pragma unroll
            for (int j = 0; j < 8; ++j) { gg[j] = lnbg[8 * lane + j]; gg[8 + j] = lnbg[512 + 8 * lane + j]; bb[j] = lnbb[8 * lane + j]; bb[8 + j] = lnbb[512 + 8 * lane + j]; }
            for (int r = wid; r < 64; r += 8) {
                bf16_t* rowp = CB + (size_t)(t0 + r) * D;
                float x[16], mean, rstd; row16_load(rowp, lane, x); row16_stats(x, mean, rstd);
                u32x4 o0, o1;
#pragma unroll
                for (int j = 0; j < 4; ++j) {
                    o0[j] = cvt_pk_bf16(siluf_((x[2 * j] - mean) * rstd * gg[2 * j] + bb[2 * j]), siluf_((x[2 * j + 1] - mean) * rstd * gg[2 * j + 1] + bb[2 * j + 1]));
                    o1[j] = cvt_pk_bf16(siluf_((x[8 + 2 * j] - mean) * rstd * gg[8 + 2 * j] + bb[8 + 2 * j]), siluf_((x[8 + 2 * j + 1] - mean) * rstd * gg[8 + 2 * j + 1] + bb[8 + 2 * j + 1]));
                }
                *(u32x4*)(rowp + 8 * lane) = o0; *(u32x4*)(rowp + 512 + 8 * lane) = o1;
            }
        }
        const int wr = wid >> 2, wc = wid & 3;
        if (MIDPART & 16) for (int h = 0; h < NHC; ++h) {
            for (int idx = tid; idx < 64 * 16; idx += 512) {
                const int pr = idx >> 4, q8 = idx & 15; const float* s = Ws + ((size_t)h * 128 + half * 64 + pr) * 128 + q8 * 8;
                const f32x4 a = *(const f32x4*)s, b = *(const f32x4*)(s + 4);
                u32x4 o; o.x = cvt_pk_bf16(a[0], a[1]); o.y = cvt_pk_bf16(a[2], a[3]); o.z = cvt_pk_bf16(b[0], b[1]); o.w = cvt_pk_bf16(b[2], b[3]);
                *(LAS u32x4*)(SA + pr * MC_LD + q8 * 16) = o;
            }
            for (int idx = tid; idx < 2048; idx += 512) {
                const int q = idx & 127, c8 = idx >> 7, c0 = h * 128 + c8 * 8;
                const u32x4 vv = *(const u32x4*)(V + (size_t)(ch0 + q) * D + c0);
                const float mean = statL[2 * q], rstd = statL[2 * q + 1];
#pragma unroll
                for (int j = 0; j < 4; ++j) {
                    const float y0 = (bf_lo(vv[j]) - mean) * rstd * lncg[c0 + 2 * j] + lncb[c0 + 2 * j];
                    const float y1 = (bf_hi(vv[j]) - mean) * rstd * lncg[c0 + 2 * j + 1] + lncb[c0 + 2 * j + 1];
                    const unsigned pk = cvt_pk_bf16(y0, y1);
                    *(LAS unsigned short*)(SB + (c8 * 8 + 2 * j) * MC_LD + q * 2) = (unsigned short)(pk & 0xffffu);
                    *(LAS unsigned short*)(SB + (c8 * 8 + 2 * j + 1) * MC_LD + q * 2) = (unsigned short)(pk >> 16);
                }
            }
            asm volatile("s_waitcnt lgkmcnt(0)" ::: "memory"); __syncthreads();
            f32x4 acc[2][2];
#pragma unroll
            for (int m = 0; m < 2; ++m)
#pragma unroll
                for (int nn = 0; nn < 2; ++nn) acc[m][nn] = (f32x4){0.f, 0.f, 0.f, 0.f};
#pragma unroll
            for (int ks = 0; ks < 4; ++ks) {
                bf16x8 a[2], b[2];
#pragma unroll
                for (int m = 0; m < 2; ++m) a[m] = *(const LAS bf16x8*)(SA + (wr * 32 + m * 16 + fr) * MC_LD + ks * 64 + fq * 16);
#pragma unroll
                for (int nn = 0; nn < 2; ++nn) b[nn] = *(const LAS bf16x8*)(SB + (wc * 32 + nn * 16 + fr) * MC_LD + ks * 64 + fq * 16);
#pragma unroll
                for (int m = 0; m < 2; ++m)
#pragma unroll
                    for (int nn = 0; nn < 2; ++nn) acc[m][nn] = __builtin_amdgcn_mfma_f32_16x16x32_bf16(b[nn], a[m], acc[m][nn], 0, 0, 0);
            }
#pragma unroll
            for (int m = 0; m < 2; ++m) {
                const int pr = wr * 32 + m * 16 + fr; const float bias = bs[h * 128 + half * 64 + pr];
#pragma unroll
                for (int nn = 0; nn < 2; ++nn) {
                    bf16_t* up = U + (size_t)(t0 + pr) * D + h * 128 + wc * 32 + nn * 16 + 4 * fq;
                    const f32x4 uu = load4bf(up);
                    store4bf(up, uu * (acc[m][nn] + bias));
                }
            }
            asm volatile("s_waitcnt lgkmcnt(0)" ::: "memory"); __syncthreads();
        }
    }
}

namespace pg8 {
constexpr int BM = 256, BK = 64, HALF = 128, HTB = HALF * BK * 2  , STAGE_BYTES = 8 * HTB, NXCD = 8, WGM = 8;
__device__ __forceinline__ int lds_byte(int r, int c) { const int st = (r >> 4) * 2 + (c >> 5), rr = r & 15, cc = c & 31, ob = rr * 64 + cc * 2; return st * 1024 + (ob ^ (((ob >> 9) & 1) << 5)); }
__device__ __forceinline__ void stage_rc(int b, int& R, int& C) { const int st = b / 1024, sb = b % 1024, swz = sb ^ (((sb >> 9) & 1) << 5); R = (st >> 1) * 16 + swz / 64; C = (st & 1) * 32 + (swz % 64) / 2; }
struct Unit { int pm, pn, e, it, ne; };
struct StaticOrder {
    int nM, nN, nwg, G, c;
    __device__ __forceinline__ void init(int M, int N, int G_, int c_) { nM = M / BM; nN = N / BM; nwg = nM * nN; G = G_; c = c_; }
    __device__ __forceinline__ bool next(int i, int& pm, int& pn) const {
        const long L = (long)i * G + c; if (L >= nwg) return false;
        int wgid = (int)L; { const int q = nwg / NXCD, r = nwg % NXCD, xcd = wgid % NXCD, off = wgid / NXCD; wgid = (xcd < r ? xcd * (q + 1) : r * (q + 1) + (xcd - r) * q) + off; }
        const int nig = WGM * nN, gid = wgid / nig, fm = gid * WGM, gsz = (nM - fm) < WGM ? (nM - fm) : WGM;
        pm = fm + ((wgid % nig) % gsz); pn = (wgid % nig) / gsz; return true;
    }
};
template <class Epi> __device__ __forceinline__ void run_epi(const Epi& E, f32x4 (&acc)[2][2][4][2], const Unit& u, int wr, int wc, int fr, int fq) {
#pragma unroll
    for (int ai = 0; ai < 2; ++ai)
#pragma unroll
        for (int m = 0; m < 4; ++m) {
            const int ru = u.pm * BM + ai * HALF + wr * 64 + m * 16;
#pragma unroll
            for (int bj = 0; bj < 2; ++bj) E.pair(u, ru, u.pn * BM + bj * HALF + wc * 32, fr, fq, acc[ai][bj][m][0], acc[ai][bj][m][1]);
            asm volatile("" ::: "memory");
        }
}
template <class Prob, bool ALIGN_EPI>
__device__ __forceinline__ void gemm_phase(LAS unsigned char* lds, const Prob& P, int tid) {
    const int wid = __builtin_amdgcn_readfirstlane(tid >> 6), lane = tid & 63, wr = wid >> 2, wc = wid & 3, fr = lane & 15, fq = lane >> 4;
    const int K = P.K, nt = K / BK;
    unsigned voffA[2], voffB[2]; int sR[2], sC[2];
#pragma unroll
    for (int i = 0; i < 2; ++i) { stage_rc(tid * 16 + i * 8192, sR[i], sC[i]); voffA[i] = (unsigned)(sR[i] * K + sC[i]) * 2u; voffB[i] = voffA[i]; }
    const size_t kstep = (size_t)(BK * 2);
    const size_t hstep = (size_t)HALF * K * 2;
    const unsigned ldsw = (unsigned)wid * 1024u;
    const int aoff = lds_byte(wr * 64 + fr, fq * 8), boff = lds_byte(wc * 32 + fr, fq * 8);
#define PG8_SA(b, h) (((b) * 2 + (h)) * HTB)
#define PG8_SB(b, h) ((4 + (b) * 2 + (h)) * HTB)
#define PG8_STAGE(bufoff, gbase, voff) do { _Pragma("unroll") for (int _i = 0; _i < 2; ++_i) \
        __builtin_amdgcn_global_load_lds((const unsigned*)((const char*)(gbase) + (voff)[_i]), (LAS unsigned*)(lds + (bufoff) + ldsw + _i * 8192), 16, 0, 0); } while (0)
#define PG8_STAGE_A(bufoff, ptr, h, go) do { if constexpr (Prob::GATHER) PG8_STAGE(bufoff, ptr, (go)[h]); else PG8_STAGE(bufoff, (ptr) + (h) * hstep, voffA); } while (0)
#define PG8_LDA(dst, b, h) do { _Pragma("unroll") for (int m = 0; m < 4; ++m) _Pragma("unroll") for (int k = 0; k < 2; ++k) dst[m][k] = *(const LAS bf16x8*)(lds + PG8_SA(b, h) + aoff + m * 2048 + k * 1024); } while (0)
#define PG8_LDB(dst, b, h) do { _Pragma("unroll") for (int n = 0; n < 2; ++n) _Pragma("unroll") for (int k = 0; k < 2; ++k) dst[n][k] = *(const LAS bf16x8*)(lds + PG8_SB(b, h) + boff + n * 2048 + k * 1024); } while (0)
#define PG8_MMA(ai, bj, At, Bt) do { __builtin_amdgcn_s_setprio(1); _Pragma("unroll") for (int m = 0; m < 4; ++m) _Pragma("unroll") for (int n = 0; n < 2; ++n) _Pragma("unroll") for (int k = 0; k < 2; ++k) \
        acc[ai][bj][m][n] = __builtin_amdgcn_mfma_f32_16x16x32_bf16(Bt[n][k], At[m][k], acc[ai][bj][m][n], 0, 0, 0); __builtin_amdgcn_s_setprio(0); } while (0)
#define PG8_WAIT_V(n) asm volatile("s_waitcnt vmcnt(" #n ")" ::: "memory")
#define PG8_WAIT_L(n) asm volatile("s_waitcnt lgkmcnt(" #n ")" ::: "memory")
#define PG8_BAR __builtin_amdgcn_s_barrier()
#define PG8_SCHED __builtin_amdgcn_sched_barrier(0)
    Unit cur, nxt; int ui = 0;
    if (!P.next(0, cur)) return;
    f32x4 acc[2][2][4][2];
#pragma unroll
    for (int a = 0; a < 2; ++a)
#pragma unroll
        for (int b = 0; b < 2; ++b)
#pragma unroll
            for (int m = 0; m < 4; ++m)
#pragma unroll
                for (int n = 0; n < 2; ++n) acc[a][b][m][n] = (f32x4){0.f, 0.f, 0.f, 0.f};
    bf16x8 At[4][2], B0[2][2], B1[2][2];
    const char* cA = P.abase(cur); const char* cB = P.bbase(cur);
    unsigned cgo[2][2] = {{0u, 0u}, {0u, 0u}}, ngo[2][2] = {{0u, 0u}, {0u, 0u}};
    if constexpr (Prob::GATHER) P.goffs(cur, sR, sC, cgo);
    PG8_STAGE(PG8_SB(0, 0), cB, voffB); PG8_STAGE(PG8_SB(0, 1), cB + hstep, voffB); PG8_STAGE_A(PG8_SA(0, 0), cA, 0, cgo); PG8_STAGE_A(PG8_SA(0, 1), cA, 1, cgo);
    if (wr == 1) PG8_BAR;
    PG8_WAIT_V(2); PG8_BAR;
    PG8_STAGE(PG8_SB(1, 0), cB + kstep, voffB); PG8_STAGE_A(PG8_SA(1, 0), cA + kstep, 0, cgo); PG8_STAGE(PG8_SB(1, 1), cB + hstep + kstep, voffB);
    PG8_WAIT_V(6); PG8_BAR;
    for (;;) {
        const bool has_next = P.next(ui + 1, nxt);
        const char* nA = has_next ? P.abase(nxt) : cA; const char* nB = has_next ? P.bbase(nxt) : cB;
        if constexpr (Prob::GATHER) {
            if (has_next) P.goffs(nxt, sR, sC, ngo);
            else {
#pragma unroll
                for (int h = 0; h < 2; ++h)
#pragma unroll
                    for (int i = 0; i < 2; ++i) ngo[h][i] = cgo[h][i]; }
        }
        for (int t = 0; t < nt; t += 2) {
            const bool last = (t == nt - 2);
            const char* a1 = cA + (size_t)(t + 1) * kstep;
            const char* a2 = last ? nA : cA + (size_t)(t + 2) * kstep; const char* b2 = last ? nB : cB + (size_t)(t + 2) * kstep;
            const char* a3 = a2 + kstep; const char* b3 = b2 + kstep;
            unsigned g2[2][2];
#pragma unroll
            for (int h = 0; h < 2; ++h)
#pragma unroll
                for (int i = 0; i < 2; ++i) g2[h][i] = last ? ngo[h][i] : cgo[h][i];
            PG8_LDB(B0, 0, 0); PG8_LDB(B1, 0, 1); PG8_SCHED; PG8_LDA(At, 0, 0); PG8_STAGE_A(PG8_SA(1, 1), a1, 1, cgo);
            PG8_WAIT_V(8); PG8_WAIT_L(0); PG8_BAR; PG8_MMA(0, 0, At, B0); PG8_MMA(0, 1, At, B1); PG8_BAR; PG8_SCHED;
            PG8_LDA(At, 0, 1); PG8_STAGE(PG8_SB(0, 0), b2, voffB); PG8_STAGE(PG8_SB(0, 1), b2 + hstep, voffB); PG8_STAGE_A(PG8_SA(0, 0), a2, 0, g2);
            PG8_WAIT_V(8); PG8_WAIT_L(0); PG8_BAR; PG8_MMA(1, 0, At, B0); PG8_MMA(1, 1, At, B1); PG8_BAR; PG8_SCHED;
            PG8_LDB(B0, 1, 0); PG8_LDB(B1, 1, 1); PG8_SCHED; PG8_LDA(At, 1, 0); PG8_STAGE_A(PG8_SA(0, 1), a2, 1, g2);
            PG8_WAIT_V(8); PG8_WAIT_L(0); PG8_BAR; PG8_MMA(0, 0, At, B0); PG8_MMA(0, 1, At, B1); PG8_BAR; PG8_SCHED;
            PG8_LDA(At, 1, 1); PG8_STAGE(PG8_SB(1, 0), b3, voffB); PG8_STAGE(PG8_SB(1, 1), b3 + hstep, voffB); PG8_STAGE_A(PG8_SA(1, 0), a3, 0, g2);
            PG8_WAIT_V(8); PG8_WAIT_L(0); PG8_BAR; PG8_MMA(1, 0, At, B0); PG8_MMA(1, 1, At, B1); PG8_BAR; PG8_SCHED;
        }
        if constexpr (ALIGN_EPI) { if (wr == 0) PG8_BAR; }
        P.epi(acc, cur, wr, wc, fr, fq);
        if (!has_next) break;
        if (!(Prob::CHAIN && P.chain(cur)))
#pragma unroll
        for (int a = 0; a < 2; ++a)
#pragma unroll
            for (int b = 0; b < 2; ++b)
#pragma unroll
                for (int m = 0; m < 4; ++m)
#pragma unroll
                    for (int n = 0; n < 2; ++n) acc[a][b][m][n] = (f32x4){0.f, 0.f, 0.f, 0.f};
        cur = nxt; cA = nA; cB = nB; ++ui;
        if constexpr (Prob::GATHER) {
#pragma unroll
            for (int h = 0; h < 2; ++h)
#pragma unroll
                for (int i = 0; i < 2; ++i) cgo[h][i] = ngo[h][i]; }
        if constexpr (ALIGN_EPI) { if (wr == 1) PG8_BAR; }
    }
    PG8_WAIT_V(0);
    if constexpr (!ALIGN_EPI) { if (wr == 0) PG8_BAR; }
    PG8_BAR;
#undef PG8_SA
#undef PG8_SB
#undef PG8_STAGE
#undef PG8_STAGE_A
#undef PG8_LDA
#undef PG8_LDB
#undef PG8_MMA
#undef PG8_WAIT_V
#undef PG8_WAIT_L
#undef PG8_BAR
#undef PG8_SCHED
}
}
using pg8::Unit;

constexpr size_t TSTEP_D = (size_t)256 * D * 2;
__device__ __forceinline__ int pcu(int cu) { return 32 * (cu >> 6) + 16 * ((cu >> 5) & 1); }
struct ProbInProj {
    static constexpr bool GATHER = false, CHAIN = false; __device__ __forceinline__ bool chain(const Unit&) const { return false; }
    const bf16_t* A; const bf16_t* Bt; int K; pg8::StaticOrder S; rsrc_t wsr;
    __device__ __forceinline__ bool next(int i, Unit& u) const { int pm, pn; if (!S.next(i, pm, pn)) return false; u.pm = pm; u.pn = pn; u.e = 0; u.it = 0; u.ne = 0; return true; }
    __device__ __forceinline__ const char* abase(const Unit& u) const { return (const char*)A + (size_t)u.pm * TSTEP_D; }
    __device__ __forceinline__ const char* bbase(const Unit& u) const { return (const char*)Bt + (size_t)u.pn * TSTEP_D; }
    __device__ __forceinline__ void goffs(const Unit&, const int (&)[2], const int (&)[2], unsigned (&)[2][2]) const {}
    __device__ __forceinline__ void pair(const Unit&, int ru, int cu, int fr, int fq, f32x4 va, f32x4 vb) const {
        const unsigned v1 = (unsigned)(fr * (D * 2) + fq * 8), row1 = (unsigned)ru * (unsigned)(D * 2);
        if (cu < 2048) bst4bf(wsr, v1, (unsigned)WS_QA + row1 + (unsigned)pcu(cu) * 2u, va * vb);
        else if (cu < 3072) { const unsigned so = (unsigned)WS_BA + row1 + (unsigned)(cu - 2048) * 2u; bst4bf(wsr, v1, so, va); bst4bf(wsr, v1 + 32u, so, vb); }
        else if (cu < 5120) { const unsigned zr = (unsigned)(ru + ZPAD + 2 * ZPAD * (ru >= SEQ ? 1 : 0)) * (unsigned)(D * 2); bst4bf(wsr, v1, (unsigned)WS_ZB + zr + (unsigned)pcu(cu - 3072) * 2u, va * sig4(vb)); }
        else if (cu < 7168) { const int cc = cu - 5120; const unsigned so = (cc < 1024 ? (unsigned)WS_U + (unsigned)cc * 2u : (unsigned)WS_V + (unsigned)(cc - 1024) * 2u) + row1; bst4bf(wsr, v1, so, gelu4(va)); bst4bf(wsr, v1 + 32u, so, gelu4(vb)); }
        else { const unsigned v3 = (unsigned)(fr * (3 * D * 2) + fq * 8), so = (unsigned)WS_G + (unsigned)ru * (unsigned)(3 * D * 2) + (unsigned)(cu - 7168) * 2u; bst4bf(wsr, v3, so, sig4(va)); bst4bf(wsr, v3 + 32u, so, sig4(vb)); }
    }
    __device__ __forceinline__ void epi(f32x4 (&acc)[2][2][4][2], const Unit& u, int wr, int wc, int fr, int fq) const { pg8::run_epi(*this, acc, u, wr, wc, fr, fq); }
};
struct ProbBranch {
    static constexpr bool GATHER = false, CHAIN = true;
    const unsigned char* ws; int K; pg8::StaticOrder S; rsrc_t wsr;
    __device__ __forceinline__ bool chain(const Unit& u) const { return u.e < 2; }
    __device__ __forceinline__ bool next(int i, Unit& u) const { int pm, pn; if (!S.next(i / 3, pm, pn)) return false; u.pm = pm; u.pn = pn; u.e = i % 3; u.it = 0; u.ne = 0; return true; }
    __device__ __forceinline__ const char* abase(const Unit& u) const { return (const char*)ws + WS_BA + (size_t)u.e * (WS_CB - WS_BA) + (size_t)u.pm * TSTEP_D; }
    __device__ __forceinline__ const char* bbase(const Unit& u) const { return (const char*)ws + WS_WA + (size_t)u.e * (WS_WB - WS_WA) + (size_t)u.pn * TSTEP_D; }
    __device__ __forceinline__ void goffs(const Unit&, const int (&)[2], const int (&)[2], unsigned (&)[2][2]) const {}
    __device__ __forceinline__ void pair(const Unit& u, int ru, int cu, int fr, int fq, f32x4& va, f32x4& vb) const {
        const unsigned v3 = (unsigned)(fr * (3 * D * 2) + fq * 8), sg = (unsigned)WS_G + (unsigned)ru * (unsigned)(3 * D * 2) + (unsigned)(u.e * D + cu) * 2u;
        const f32x4 ga = bld4bf(wsr, v3, sg), gb = bld4bf(wsr, v3 + 32u, sg);
        if (u.e < 2) {
            const f32x4 na = bld4bf(wsr, v3, sg + (unsigned)(D * 2)), nb = bld4bf(wsr, v3 + 32u, sg + (unsigned)(D * 2));
#pragma unroll
            for (int j = 0; j < 4; ++j) { va[j] = va[j] * ga[j] * __builtin_amdgcn_rcpf(fmaxf(na[j], 1e-30f)); vb[j] = vb[j] * gb[j] * __builtin_amdgcn_rcpf(fmaxf(nb[j], 1e-30f)); }
        } else {
            const unsigned v1 = (unsigned)(fr * (D * 2) + fq * 8), so = (unsigned)WS_H + (unsigned)ru * (unsigned)(D * 2) + (unsigned)cu * 2u;
            bst4bf(wsr, v1, so, va * ga); bst4bf(wsr, v1 + 32u, so, vb * gb);
        }
    }
    __device__ __forceinline__ void epi(f32x4 (&acc)[2][2][4][2], const Unit& u, int wr, int wc, int fr, int fq) const { pg8::run_epi(*this, acc, u, wr, wc, fr, fq); }
};
struct ProbWo {
    static constexpr bool GATHER = false, CHAIN = false; __device__ __forceinline__ bool chain(const Unit&) const { return false; }
    const bf16_t* A; const bf16_t* Bt; int K; pg8::StaticOrder S;
    rsrc_t xin, xout;
    __device__ __forceinline__ bool next(int i, Unit& u) const { int pm, pn; if (!S.next(i, pm, pn)) return false; u.pm = pm; u.pn = pn; u.e = 0; u.it = 0; u.ne = 0; return true; }
    __device__ __forceinline__ const char* abase(const Unit& u) const { return (const char*)A + (size_t)u.pm * TSTEP_D; }
    __device__ __forceinline__ const char* bbase(const Unit& u) const { return (const char*)Bt + (size_t)u.pn * TSTEP_D; }
    __device__ __forceinline__ void goffs(const Unit&, const int (&)[2], const int (&)[2], unsigned (&)[2][2]) const {}
    __device__ __forceinline__ void pair(const Unit&, int ru, int cu, int fr, int fq, f32x4 va, f32x4 vb) const {
        const unsigned v = (unsigned)(fr * (D * 4) + fq * 16), so = (unsigned)ru * (unsigned)(D * 4) + (unsigned)cu * 4u;
        const f32x4 xa = bld4f(xin, v, so), xb = bld4f(xin, v + 64u, so);
        bst4f(xout, v, so, xa + va); bst4f(xout, v + 64u, so, xb + vb);
    }
    __device__ __forceinline__ void epi(f32x4 (&acc)[2][2][4][2], const Unit& u, int wr, int wc, int fr, int fq) const { pg8::run_epi(*this, acc, u, wr, wc, fr, fq); }
};
constexpr int MOE_TAB_MAX = 192;
__device__ __forceinline__ void moe_build_table(const unsigned* cnt, LAS int* cntL, LAS int* tab, LAS int* ntl, int tid) {
    if (tid < NE) cntL[tid] = (int)ld_agent(cnt + tid);
    __syncthreads();
    if (tid == 0) { int acc = 0; for (int e = 0; e < NE; ++e) { const int nt = (cntL[e] + 255) >> 8; for (int it = 0; it < nt; ++it) tab[acc + it] = (e << 8) | it; acc += nt; } ntl[0] = acc; }
    __syncthreads();
}
__device__ __forceinline__ bool moe_next(int i, int G, int c, int ntiles, const LAS int* tab, const LAS int* cntL, Unit& u) {
    const int L = i * G + c; if (L >= 4 * ntiles) return false;
    const int ti = L >> 2, ent = __builtin_amdgcn_readfirstlane(tab[ti]);
    u.pm = ti; u.pn = L & 3; u.e = ent >> 8; u.it = ent & 255; u.ne = __builtin_amdgcn_readfirstlane(cntL[ent >> 8]); return true;
}
struct ProbMoe1 {
    static constexpr bool GATHER = true, CHAIN = false; __device__ __forceinline__ bool chain(const Unit&) const { return false; }
    const bf16_t* H2; const bf16_t* W13; int K; int G, c;
    const LAS int* cntL; const LAS int* tab; int ntiles;
    rsrc_t wsr;
    __device__ __forceinline__ bool next(int i, Unit& u) const { return moe_next(i, G, c, ntiles, tab, cntL, u); }
    __device__ __forceinline__ const char* abase(const Unit&) const { return (const char*)H2; }
    __device__ __forceinline__ const char* bbase(const Unit& u) const { return (const char*)W13 + ((size_t)u.e * 1024 + (size_t)u.pn * 256) * D * 2; }
    __device__ __forceinline__ void goffs(const Unit& u, const int (&R)[2], const int (&C)[2], unsigned (&o)[2][2]) const {
#pragma unroll
        for (int h = 0; h < 2; ++h)
#pragma unroll
            for (int i = 0; i < 2; ++i) {
                const int idx = u.it * 256 + h * 128 + R[i];
                const int tok = (int)__builtin_amdgcn_raw_buffer_load_b32(wsr, (unsigned)(R[i] * 4), (unsigned)WS_STOK + (unsigned)(u.e * CAP + u.it * 256 + h * 128) * 4u, 0);
                o[h][i] = (unsigned)((idx < u.ne ? tok : T) * D + C[i]) * 2u;
            }
    }
    __device__ __forceinline__ void pair(const Unit&, int ru, int cu, int fr, int fq, f32x4 va, f32x4 vb) const {
        bst4bf(wsr, (unsigned)(fr * (DFF * 2) + fq * 8), (unsigned)WS_ACT + (unsigned)ru * (unsigned)(DFF * 2) + (unsigned)pcu(cu) * 2u, silu4(va) * vb);
    }
    __device__ __forceinline__ void epi(f32x4 (&acc)[2][2][4][2], const Unit& u, int wr, int wc, int fr, int fq) const { pg8::run_epi(*this, acc, u, wr, wc, fr, fq); }
};
struct ProbMoe2 {
    static constexpr bool GATHER = false, CHAIN = false; __device__ __forceinline__ bool chain(const Unit&) const { return false; }
    const bf16_t* ACT; const bf16_t* W2; int K; int G, c;
    const LAS int* cntL; const LAS int* tab; int ntiles;
    rsrc_t wsr;
    __device__ __forceinline__ bool next(int i, Unit& u) const { return moe_next(i, G, c, ntiles, tab, cntL, u); }
    __device__ __forceinline__ const char* abase(const Unit& u) const { return (const char*)ACT + (size_t)u.pm * 256 * DFF * 2; }
    __device__ __forceinline__ const char* bbase(const Unit& u) const { return (const char*)W2 + ((size_t)u.e * 1024 + (size_t)u.pn * 256) * DFF * 2; }
    __device__ __forceinline__ void goffs(const Unit&, const int (&)[2], const int (&)[2], unsigned (&)[2][2]) const {}
    __device__ __forceinline__ void pair(const Unit& u, int ru, int cu, int fr, int fq, f32x4 va, f32x4 vb) const {
        const int rloc = ru - u.pm * 256, idx = u.it * 256 + rloc + fr;
        const unsigned ss = (unsigned)(u.e * CAP + u.it * 256 + rloc) * 4u;
        const float w = __uint_as_float(__builtin_amdgcn_raw_buffer_load_b32(wsr, (unsigned)(fr * 4), (unsigned)WS_SW + ss, 0));
        const unsigned asg = __builtin_amdgcn_raw_buffer_load_b32(wsr, (unsigned)(fr * 4), (unsigned)WS_SASG + ss, 0);
        const unsigned v = idx < u.ne ? asg * (unsigned)(D * 2) + (unsigned)(fq * 8) : 0xC0000000u;
        const unsigned so = (unsigned)WS_YC + (unsigned)cu * 2u;
        bst4bf(wsr, v, so, va * w); bst4bf(wsr, v + 32u, so, vb * w);
    }
    __device__ __forceinline__ void epi(f32x4 (&acc)[2][2][4][2], const Unit& u, int wr, int wc, int fr, int fq) const { pg8::run_epi(*this, acc, u, wr, wc, fr, fq); }
};

#define XB_TMO      128
#define XB_XCNT(j)  (256  + 64 * (j))
#define XB_XSUB(j)  (1280 + 64 * (j))
#define XB_XGEN(j)  (2304 + 64 * (j))
#define XB_TOP      3328
#define XB_TOPGEN   3392
#define XCD_BAR_WORDS 3456
#define XB_SPIN_CAP (1u << 18)
__device__ __forceinline__ unsigned xb_ld(unsigned* p)              { return __hip_atomic_load(p, __ATOMIC_RELAXED, __HIP_MEMORY_SCOPE_AGENT); }
__device__ __forceinline__ unsigned xb_add(unsigned* p, unsigned v) { return __hip_atomic_fetch_add(p, v, __ATOMIC_RELAXED, __HIP_MEMORY_SCOPE_AGENT); }
__device__ __forceinline__ unsigned xb_xcc_id() { return (unsigned)__builtin_amdgcn_s_getreg((3 << 11) | 20) & 0xFu; }
#define XB_SPIN(cond, bar) do { unsigned _sp = 0; while (cond) { __builtin_amdgcn_s_sleep(1); \
    if ((++_sp & 255u) == 0u) { if (xb_ld(&(bar)[XB_TMO])) break; if (_sp > XB_SPIN_CAP) { atomicAdd(&(bar)[XB_TMO], 1u); break; } } } } while (0)
struct XcdBarrier {
    unsigned* bar; unsigned x;
    volatile LAS unsigned* st;
};
__device__ __forceinline__ XcdBarrier xcd_barrier_post(unsigned* bar, volatile LAS unsigned* st) {
    XcdBarrier b; b.bar = bar; b.x = xb_xcc_id(); b.st = st;
    if (threadIdx.x == 0) (void)xb_add(&bar[XB_XCNT(b.x)], 1u);
    return b;
}
__device__ __forceinline__ void xcd_barrier_complete(unsigned* bar, unsigned x, unsigned& nloc, unsigned& nx) {
    const unsigned G = gridDim.x * gridDim.y * gridDim.z;
    unsigned sum, cnt, mine, sp = 0u;
    for (;;) {
        sum = 0u; cnt = 0u; mine = 0u;
#pragma unroll
        for (unsigned j = 0; j < 16; ++j) { const unsigned c = xb_ld(&bar[XB_XCNT(j)]); sum += c; cnt += (c > 0u) ? 1u : 0u; mine = (j == x) ? c : mine; }
        if (sum == G) break;
        __builtin_amdgcn_s_sleep(1);
        if ((++sp & 255u) == 0u) { if (xb_ld(&bar[XB_TMO])) break; if (sp > XB_SPIN_CAP) { atomicAdd(&bar[XB_TMO], 1u); break; } }
    }
    nloc = mine > 0u ? mine : 1u; nx = cnt > 0u ? cnt : 1u;
}
__device__ __forceinline__ void xcd_barrier(const XcdBarrier& b) {
    asm volatile("s_waitcnt vmcnt(0)" ::: "memory");
    __syncthreads();
    if (threadIdx.x == 0) {
        unsigned* bar = b.bar;
        __builtin_amdgcn_s_waitcnt(0);
        unsigned nloc = b.st[0], nx = b.st[1];
        if (nloc == 0u) { xcd_barrier_complete(bar, b.x, nloc, nx); b.st[0] = nloc; b.st[1] = nx; }
        const unsigned old = xb_add(&bar[XB_XSUB(b.x)], 1u);
        const unsigned gen = old / nloc;
        if (old + 1u == (gen + 1u) * nloc) {
            __builtin_amdgcn_fence(__ATOMIC_RELEASE, "agent");
            asm volatile("s_waitcnt vmcnt(0)" ::: "memory");
            const unsigned og = xb_add(&bar[XB_TOP], 1u);
            const unsigned tg = og / nx;
            if (og + 1u == (tg + 1u) * nx) xb_add(&bar[XB_TOPGEN], 1u);
            else XB_SPIN(xb_ld(&bar[XB_TOPGEN]) == tg, bar);
            __builtin_amdgcn_fence(__ATOMIC_ACQUIRE, "agent");
            xb_add(&bar[XB_XGEN(b.x)], 1u);
            asm volatile("s_waitcnt vmcnt(0)" ::: "memory");
        } else {
            XB_SPIN(xb_ld(&bar[XB_XGEN(b.x)]) == gen, bar);
            __builtin_amdgcn_fence(__ATOMIC_ACQUIRE, "agent");
            asm volatile("s_waitcnt vmcnt(0)" ::: "memory");
        }
    }
    __syncthreads();
}

static_assert(MOE_OFF + (32 + MOE_TAB_MAX + 4) * 4 <= RT_LOG && MID_LDS <= RING_BYTES, "LDS map");
static_assert(WS_U - WS_CB == WS_CB - WS_BA && WS_WC - WS_WB == WS_WB - WS_WA, "branch operands equally spaced");
constexpr int NPH = 8 * NL + 1;

struct Args { const float* in[24]; float* out; unsigned char* ws; int ph_lo, ph_hi, bar_region, pad; CvtTable tb[NL]; };
#define WSA(type, off) ((type*)(a->ws + (off)))
#define KARGS() ({ const CAS Args* q_ = kp; asm volatile("" : "+s"(q_)); q_; })

__global__ void __launch_bounds__(512, 2) mk_fwd(Args a_unused) {
    extern __shared__ __attribute__((aligned(16))) unsigned char lds_[];
    LAS unsigned char* lds = (LAS unsigned char*)lds_;
    volatile LAS unsigned* MISC = (volatile LAS unsigned*)(lds + MISC_OFF);
    for (int u = threadIdx.x; u < (LDS_BYTES - LDSCTL_OFF) / 4; u += 512) ((LAS unsigned*)(lds + LDSCTL_OFF))[u] = 0u;
    __syncthreads();
    const CAS Args* kp = (const CAS Args*)__builtin_amdgcn_kernarg_segment_ptr();
    int lo, hi; XcdBarrier bar;
    { const CAS Args* a = KARGS(); lo = a->ph_lo; hi = a->ph_hi; bar = xcd_barrier_post(WSA(unsigned, WS_CTL) + CW_BAR + a->bar_region * XCD_BAR_WORDS, MISC + 8); }
#ifndef PHMASK
#define PHMASK 0x1ff
#endif
#define IN(k) (((PHMASK >> (((k) == 8 * NL) ? 8 : ((k) & 7))) & 1) && lo <= (k) && (k) < hi)
#define PHASE_REGS() int tid = threadIdx.x; asm volatile("" : "+v"(tid)); int bid = blockIdx.x, G = gridDim.x; asm volatile("" : "+s"(bid), "+s"(G))
#define SEAM(k) do { if ((k) + 1 < hi) xcd_barrier(bar); } while (0)
    LAS int* cntL = (LAS int*)(lds + MOE_OFF); LAS int* tabL = cntL + 32; LAS int* ntl = tabL + MOE_TAB_MAX;

    for (int l = 0; l < NL; ++l) {
        const int k0 = 8 * l;
        if (IN(k0 + 0)) {
            PHASE_REGS(); const CAS Args* a = KARGS(); bf16_t* const Hb = WSA(bf16_t, WS_H); unsigned* const ctl = WSA(unsigned, WS_CTL); (void)ctl; (void)Hb;
            cvt_phase(&a->tb[l], (LAS float*)lds, tid, bid, G);
            if (l == 0 && bid < 4) { unsigned* z = WSA(unsigned, WS_ZB) + (size_t)((bid >> 1) * ZSEQ + (bid & 1) * (SEQ + ZPAD)) * (D / 2); for (int i = tid; i < ZPAD * D / 2; i += 512) z[i] = 0u; }
            if (l == 0) norm_phase<false, false>(a->in[0], nullptr, nullptr, a->in[1], Hb, nullptr, tid, bid, G);
            else norm_phase<true, false>(a->out, a->out, WSA(bf16_t, WS_YC), a->in[1] + l * D, Hb, nullptr, tid, bid, G);
            SEAM(k0 + 0);
        }
        if (IN(k0 + 1)) {
            PHASE_REGS(); const CAS Args* a = KARGS(); bf16_t* const Hb = WSA(bf16_t, WS_H); unsigned* const ctl = WSA(unsigned, WS_CTL); (void)ctl; (void)Hb;
            ProbInProj P; P.A = Hb; P.Bt = WSA(bf16_t, WS_WIN); P.K = D; P.S.init(T, DIN, G, bid);
            P.wsr = mkrsrc(a->ws, (unsigned)WS_END);
            pg8::gemm_phase<ProbInProj, true>(lds, P, tid);
            SEAM(k0 + 1);
        }
        if (IN(k0 + 2)) {
            PHASE_REGS(); const CAS Args* a = KARGS(); bf16_t* const Hb = WSA(bf16_t, WS_H); unsigned* const ctl = WSA(unsigned, WS_CTL); (void)ctl; (void)Hb;
            mid_phase(mkrsrc(a->ws, (unsigned)WS_END), WSA(bf16_t, WS_QA), WSA(bf16_t, WS_BA), WSA(bf16_t, WS_CB), WSA(bf16_t, WS_V), WSA(bf16_t, WS_U),
                      a->in[3] + (size_t)l * 3 * D, a->in[5] + (size_t)l * 31 * D, a->in[6] + l * D, a->in[7] + l * D, a->in[9] + l * D, a->in[10] + l * D,
                      a->in[11] + (size_t)l * NHC * 128 * 128, a->in[12] + l * NHC * 128, lds, tid, bid, G);
            SEAM(k0 + 2);
        }
        if (IN(k0 + 3)) {
            PHASE_REGS(); const CAS Args* a = KARGS(); bf16_t* const Hb = WSA(bf16_t, WS_H); unsigned* const ctl = WSA(unsigned, WS_CTL); (void)ctl; (void)Hb;
            ProbBranch P; P.ws = a->ws;
            P.K = D; P.S.init(T, D, G, bid); P.wsr = mkrsrc(a->ws, (unsigned)WS_END);
            pg8::gemm_phase<ProbBranch, true>(lds, P, tid);
            SEAM(k0 + 3);
        }
        if (IN(k0 + 4)) {
            PHASE_REGS(); const CAS Args* a = KARGS(); bf16_t* const Hb = WSA(bf16_t, WS_H); unsigned* const ctl = WSA(unsigned, WS_CTL); (void)ctl; (void)Hb;
            ProbWo P; P.A = Hb; P.Bt = WSA(bf16_t, WS_WO); P.K = D; P.S.init(T, D, G, bid); P.xin = mkrsrc((l == 0) ? a->in[0] : a->out, (unsigned)((size_t)T * D * 4)); P.xout = mkrsrc(a->out, (unsigned)((size_t)T * D * 4));
            pg8::gemm_phase<ProbWo, false>(lds, P, tid);
            SEAM(k0 + 4);
        }
        if (IN(k0 + 5)) {
            PHASE_REGS(); const CAS Args* a = KARGS(); bf16_t* const Hb = WSA(bf16_t, WS_H); unsigned* const ctl = WSA(unsigned, WS_CTL); (void)ctl; (void)Hb;
            router_phase(a->out, a->in[15] + l * D, a->in[16] + (size_t)l * D * NG, a->in[17] + l * NG, a->in[18] + (size_t)l * D * NE, a->in[19] + l * NE,
                         Hb, ctl + CW_CNT + 64 * l, WSA(int, WS_STOK), WSA(float, WS_SW), WSA(int, WS_SASG), lds, tid, bid, G);
            SEAM(k0 + 5);
        }
        if (IN(k0 + 6)) {
            PHASE_REGS(); const CAS Args* a = KARGS(); bf16_t* const Hb = WSA(bf16_t, WS_H); unsigned* const ctl = WSA(unsigned, WS_CTL); (void)ctl; (void)Hb;
            moe_build_table(ctl + CW_CNT + 64 * l, cntL, tabL, ntl, tid);
            ProbMoe1 P; P.H2 = Hb; P.W13 = WSA(bf16_t, WS_W13); P.K = D; P.G = G; P.c = bid; P.cntL = cntL; P.tab = tabL; P.ntiles = __builtin_amdgcn_readfirstlane(ntl[0]); P.wsr = mkrsrc(a->ws, (unsigned)WS_END);
            pg8::gemm_phase<ProbMoe1, true>(lds, P, tid);
            SEAM(k0 + 6);
        }
        if (IN(k0 + 7)) {
            PHASE_REGS(); const CAS Args* a = KARGS(); bf16_t* const Hb = WSA(bf16_t, WS_H); unsigned* const ctl = WSA(unsigned, WS_CTL); (void)ctl; (void)Hb;
            moe_build_table(ctl + CW_CNT + 64 * l, cntL, tabL, ntl, tid);
            ProbMoe2 P; P.ACT = WSA(bf16_t, WS_ACT); P.W2 = WSA(bf16_t, WS_W2); P.K = DFF; P.G = G; P.c = bid; P.cntL = cntL; P.tab = tabL; P.ntiles = __builtin_amdgcn_readfirstlane(ntl[0]); P.wsr = mkrsrc(a->ws, (unsigned)WS_END);
            pg8::gemm_phase<ProbMoe2, true>(lds, P, tid);
            SEAM(k0 + 7);
        }
    }
    if (IN(8 * NL)) { PHASE_REGS(); const CAS Args* a = KARGS(); norm_phase<true, true>(a->out, nullptr, WSA(bf16_t, WS_YC), a->in[23], nullptr, a->out, tid, bid, G); }
#undef IN
#undef SEAM
}

static void build_cvt(CvtTable& tb, void* const* d_in, unsigned char* ws, int l) {
    const float* w_in = (const float*)d_in[2] + (size_t)l * D * DIN;
    auto set = [&](int i, const float* A, const float* B, bf16_t* dst, int ld, int K, int ndst, int pair, int cA, int cB, int batch, long sb, long db) {
        CvtDesc& c = tb.d[i]; c.A = A; c.B = B; c.dst = dst; c.ld = ld; c.K = K; c.ndst = ndst; c.pair = pair; c.colA0 = cA; c.colB0 = cB; c.batch = batch; c.sbatch = sb; c.dbatch = db;
        c.items = batch * (ndst / 64) * (K / 64); };
    bf16_t* win = (bf16_t*)(ws + WS_WIN);
    set(0, w_in, w_in, win, DIN, D, 2048, 1, 0, 2048, 1, 0, 0);
    set(1, w_in, nullptr, win + (size_t)2048 * D, DIN, D, 1024, 0, 1024, 0, 1, 0, 0);
    set(2, w_in, w_in, win + (size_t)3072 * D, DIN, D, 2048, 1, 3072, 4096, 1, 0, 0);
    set(3, w_in, nullptr, win + (size_t)5120 * D, DIN, D, 2048, 0, 5120, 0, 1, 0, 0);
    set(4, w_in, nullptr, win + (size_t)7168 * D, DIN, D, 3072, 0, 7168, 0, 1, 0, 0);
    set(5, (const float*)d_in[4] + (size_t)l * D * D, nullptr, (bf16_t*)(ws + WS_WA), D, D, D, 0, 0, 0, 1, 0, 0);
    set(6, (const float*)d_in[8] + (size_t)l * D * D, nullptr, (bf16_t*)(ws + WS_WB), D, D, D, 0, 0, 0, 1, 0, 0);
    set(7, (const float*)d_in[13] + (size_t)l * D * D, nullptr, (bf16_t*)(ws + WS_WC), D, D, D, 0, 0, 0, 1, 0, 0);
    set(8, (const float*)d_in[14] + (size_t)l * D * D, nullptr, (bf16_t*)(ws + WS_WO), D, D, D, 0, 0, 0, 1, 0, 0);
    set(9, (const float*)d_in[20] + (size_t)l * NE * D * DFF, (const float*)d_in[21] + (size_t)l * NE * D * DFF, (bf16_t*)(ws + WS_W13), DFF, D, 1024, 1, 0, 0, NE, (long)D * DFF, (long)1024 * D);
    set(10, (const float*)d_in[22] + (size_t)l * NE * DFF * D, nullptr, (bf16_t*)(ws + WS_W2), D, DFF, D, 0, 0, 0, NE, (long)DFF * D, (long)D * DFF);
    tb.total = 0; for (int i = 0; i < NCVT; ++i) tb.total += tb.d[i].items; tb.pad = 0;
}

#ifndef MK_CUTS
#define MK_CUTS 0
#endif

extern "C" void kernel_launch(void* const* d_in, const int* in_sizes, int n_in, void* d_out, int out_size, void* d_ws, size_t ws_size, hipStream_t stream) {
    static int grid = 0;
    if (grid == 0) {
        if (n_in != 24 || ws_size < WS_END) { fprintf(stderr, "kernel_launch: unexpected n_in %d or ws_size %zu < %zu\n", n_in, ws_size, (size_t)WS_END); grid = -1; return; }
        int dev = 0, cus = 0, per_cu = 0;
        if (hipGetDevice(&dev) != hipSuccess || hipDeviceGetAttribute(&cus, hipDeviceAttributeMultiprocessorCount, dev) != hipSuccess) { grid = -1; return; }
        if (hipFuncSetAttribute((const void*)mk_fwd, hipFuncAttributeMaxDynamicSharedMemorySize, LDS_BYTES) != hipSuccess) { fprintf(stderr, "kernel_launch: hipFuncSetAttribute failed\n"); grid = -1; return; }
        if (hipOccupancyMaxActiveBlocksPerMultiprocessor(&per_cu, (const void*)mk_fwd, 512, LDS_BYTES) != hipSuccess || per_cu < 1) { fprintf(stderr, "kernel_launch: occupancy query says %d\n", per_cu); }
        (void)hipGetLastError();
        grid = cus;
    }
    if (grid < 0) return;
    unsigned char* ws = (unsigned char*)d_ws;
    (void)hipMemsetAsync(ws + WS_CTL, 0, CTL_BYTES, stream);
    Args a{};
    for (int i = 0; i < 24; ++i) a.in[i] = (const float*)d_in[i];
    a.out = (float*)d_out; a.ws = ws;
    for (int l = 0; l < NL; ++l) build_cvt(a.tb[l], d_in, ws, l);
#if MK_CUTS == 0
    a.ph_lo = 0; a.ph_hi = NPH; a.bar_region = 0;
    hipLaunchKernelGGL(mk_fwd, dim3(grid), dim3(512), LDS_BYTES, stream, a);
#elif MK_CUTS == 1
    for (int k = 0; k < NPH; ++k) { a.ph_lo = k; a.ph_hi = k + 1; a.bar_region = 0; hipLaunchKernelGGL(mk_fwd, dim3(grid), dim3(512), LDS_BYTES, stream, a); }
#else
    a.ph_lo = 0; a.ph_hi = 8; a.bar_region = 0; hipLaunchKernelGGL(mk_fwd, dim3(grid), dim3(512), LDS_BYTES, stream, a);
    a.ph_lo = 8; a.ph_hi = NPH; a.bar_region = 1; hipLaunchKernelGGL(mk_fwd, dim3(grid), dim3(512), LDS_BYTES, stream, a);
#endif
}
```

```cpp
#include <hip/hip_runtime.h>
#include <stdint.h>
#include <stdio.h>

#define LAS __attribute__((address_space(3)))
#define CAS __attribute__((address_space(4)))
typedef unsigned short bf16_t;
typedef short bf16x8 __attribute__((ext_vector_type(8)));
typedef float f32x4 __attribute__((ext_vector_type(4)));
typedef float f32x2 __attribute__((ext_vector_type(2)));
typedef unsigned u32x4 __attribute__((ext_vector_type(4)));
typedef unsigned u32x2 __attribute__((ext_vector_type(2)));

constexpr int T = 16384, D = 1024, SEQ = 8192, DIN = 10240, NE = 32, NG = 4, EPG = 8, DFF = 512, NHC = 8;
constexpr int CAP = 16384;
constexpr int NL = 2;
constexpr float RMS_EPS = 1e-6f, LN_EPS = 1e-5f;

constexpr size_t MiB = 1u << 20;
constexpr size_t WS_CTL = 0, CTL_BYTES = 32768;
constexpr size_t WS_WIN = 2 * MiB, WS_WA = 22 * MiB, WS_WB = 24 * MiB, WS_WC = 26 * MiB, WS_WO = 28 * MiB, WS_W13 = 30 * MiB, WS_W2 = 94 * MiB;
constexpr size_t WS_H = 126 * MiB;
constexpr size_t WS_QA = 159 * MiB, WS_BA = 191 * MiB, WS_U = 255 * MiB, WS_V = 287 * MiB, WS_G = 319 * MiB;
constexpr size_t WS_W2B = 415 * MiB;
constexpr size_t WS_ZB = 447 * MiB;
constexpr int ZPAD = 15, ZSEQ = SEQ + 2 * ZPAD;
constexpr size_t WS_CB = 223 * MiB;
constexpr size_t WS_ACT = WS_QA;
constexpr size_t WS_YC = 223 * MiB;
constexpr size_t WS_STOK = 511 * MiB, WS_SW = 513 * MiB, WS_SASG = 515 * MiB;
constexpr size_t WS_STAT = 517 * MiB;
constexpr size_t WS_END = 518 * MiB;
constexpr int CW_CNT = 0;
constexpr int CW_BAR = 1024;

__device__ __forceinline__ unsigned cvt_pk_bf16(float lo, float hi) { unsigned r; asm volatile("v_cvt_pk_bf16_f32 %0, %1, %2" : "=v"(r) : "v"(lo), "v"(hi)); return r; }
__device__ __forceinline__ float bf_lo(unsigned p) { return __uint_as_float(p << 16); }
__device__ __forceinline__ float bf_hi(unsigned p) { return __uint_as_float(p & 0xffff0000u); }
__device__ __forceinline__ float wave_sum(float v) {
#pragma unroll
    for (int o = 1; o < 64; o <<= 1) v += __shfl_xor(v, o);
    return v;
}
__device__ __forceinline__ float sigmoidf_(float x) { return __builtin_amdgcn_rcpf(1.0f + __expf(-x)); }
__device__ __forceinline__ float siluf_(float x) { return x * sigmoidf_(x); }
__device__ __forceinline__ float gelu_tanh_(float x) { const float z = 0.7978845608028654f * (x + 0.044715f * x * x * x); return x * sigmoidf_(2.0f * z); }
__device__ __forceinline__ f32x4 sig4(f32x4 v) { return (f32x4){sigmoidf_(v[0]), sigmoidf_(v[1]), sigmoidf_(v[2]), sigmoidf_(v[3])}; }
__device__ __forceinline__ f32x4 silu4(f32x4 v) { return (f32x4){siluf_(v[0]), siluf_(v[1]), siluf_(v[2]), siluf_(v[3])}; }
__device__ __forceinline__ f32x4 gelu4(f32x4 v) { return (f32x4){gelu_tanh_(v[0]), gelu_tanh_(v[1]), gelu_tanh_(v[2]), gelu_tanh_(v[3])}; }
__device__ __forceinline__ void store4bf(bf16_t* p, f32x4 v) { u32x2 w; w.x = cvt_pk_bf16(v[0], v[1]); w.y = cvt_pk_bf16(v[2], v[3]); *(u32x2*)p = w; }
__device__ __forceinline__ f32x4 load4bf(const bf16_t* p) { const u32x2 w = *(const u32x2*)p; return (f32x4){bf_lo(w.x), bf_hi(w.x), bf_lo(w.y), bf_hi(w.y)}; }
__device__ __forceinline__ unsigned ld_agent(const unsigned* p) { return __hip_atomic_load(p, __ATOMIC_RELAXED, __HIP_MEMORY_SCOPE_AGENT); }

typedef __amdgpu_buffer_rsrc_t rsrc_t;
__device__ __forceinline__ rsrc_t mkrsrc(const void* p, unsigned bytes) { return __builtin_amdgcn_make_buffer_rsrc(const_cast<void*>(p), (short)0, (int)bytes, 0x00020000); }
__device__ __forceinline__ f32x4 bld4bf(rsrc_t r, unsigned voff, unsigned soff) { const u32x2 w = __builtin_amdgcn_raw_buffer_load_b64(r, voff, soff, 0); return (f32x4){bf_lo(w.x), bf_hi(w.x), bf_lo(w.y), bf_hi(w.y)}; }
__device__ __forceinline__ void bst4bf(rsrc_t r, unsigned voff, unsigned soff, f32x4 v) { u32x2 w; w.x = cvt_pk_bf16(v[0], v[1]); w.y = cvt_pk_bf16(v[2], v[3]); __builtin_amdgcn_raw_buffer_store_b64(w, r, voff, soff, 0); }
__device__ __forceinline__ f32x4 bld4f(rsrc_t r, unsigned voff, unsigned soff) { const u32x4 w = __builtin_amdgcn_raw_buffer_load_b128(r, voff, soff, 0); return (f32x4){__uint_as_float(w.x), __uint_as_float(w.y), __uint_as_float(w.z), __uint_as_float(w.w)}; }
__device__ __forceinline__ void bst4f(rsrc_t r, unsigned voff, unsigned soff, f32x4 v) { u32x4 w; w.x = __float_as_uint(v[0]); w.y = __float_as_uint(v[1]); w.z = __float_as_uint(v[2]); w.w = __float_as_uint(v[3]); __builtin_amdgcn_raw_buffer_store_b128(w, r, voff, soff, 0); }
__device__ __forceinline__ int pair_col(int c) { return 32 * (c >> 6) + 16 * ((c >> 5) & 1) + (c & 15); }

struct CvtDesc { const float* A; const float* B; bf16_t* dst; long sbatch, dbatch; int ld, K, ndst, pair, colA0, colB0, batch, items; };
constexpr int NCVT = 11;
struct CvtTable { CvtDesc d[NCVT]; int total, pad; };

struct CvtItem { const float* A; const float* B; bf16_t* dst; int ld, K, pair, cA, cB, nb, k0; };
__device__ __forceinline__ void cvt_decode(const CAS CvtTable* tb, int dlo, int dhi, int it, CvtItem& x) {
    int r = it, di = dlo;
    while (di < dhi - 1 && r >= tb->d[di].items) { r -= tb->d[di].items; ++di; }
    const int K = tb->d[di].K, ntn = tb->d[di].ndst / 64, ntk = K / 256;
    const int b = r / (ntn * ntk), rem = r % (ntn * ntk);
    x.nb = rem / ntk; x.k0 = (rem % ntk) * 256; x.K = K; x.ld = tb->d[di].ld; x.pair = tb->d[di].pair; x.cA = tb->d[di].colA0; x.cB = tb->d[di].colB0;
    x.A = tb->d[di].A + (size_t)b * tb->d[di].sbatch; x.B = tb->d[di].B ? tb->d[di].B + (size_t)b * tb->d[di].sbatch : x.A; x.dst = tb->d[di].dst + (size_t)b * tb->d[di].dbatch;
}
__device__ __forceinline__ void cvt_load(const CvtItem& x, int tid, f32x4 (&R)[8]) {
#pragma unroll
    for (int i = 0; i < 8; ++i) {
        const int idx = tid + 512 * i, kk = idx >> 4, s16 = idx & 15;
        const float* src = (x.pair && (s16 >> 3)) ? x.B : x.A;
        const int col = x.pair ? ((s16 >> 3) ? x.cB : x.cA) + 32 * x.nb + 4 * (s16 & 7) : x.cA + 64 * x.nb + 4 * s16;
        R[i] = *(const f32x4*)(src + (size_t)(x.k0 + kk) * x.ld + col);
    }
}
__device__ __forceinline__ void cvt_phase(const CAS CvtTable* tb, int dlo, int dhi, int r, int credit, LAS float* tile, int tid, int bid, int nblk) {
    int total = 0; for (int d = dlo; d < dhi; ++d) total += tb->d[d].items;
    const int lane = tid & 63, wid = tid >> 6;
    int F = (nblk - r) * credit; F = F < total ? F : total;
    int nfront = 0; if (bid >= r) { nfront = F - (bid - r) * credit; nfront = nfront < 0 ? 0 : (nfront > credit ? credit : nfront); }
#define CVT_ITEM(j) ((j) < nfront ? (bid - r) * credit + (j) : F + ((j) - nfront) * nblk + bid)
    int j = 0, it = CVT_ITEM(0); if (it >= total) return;
    CvtItem cur, nxt; f32x4 R[8];
    cvt_decode(tb, dlo, dhi, it, cur); cvt_load(cur, tid, R);
    for (;;) {
#pragma unroll
        for (int i = 0; i < 8; ++i) {
            const int idx = tid + 512 * i, kk = idx >> 4, s16 = idx & 15;
#pragma unroll
            for (int e = 0; e < 4; ++e) {
                const int c32 = 4 * (s16 & 7) + e;
                const int nl = cur.pair ? (((c32 >> 4) * 2 + (s16 >> 3)) * 16 + (c32 & 15)) : 4 * s16 + e;
                tile[kk * 65 + nl] = R[i][e];
            }
        }
        __syncthreads();
        const int itn = CVT_ITEM(j + 1); const bool more = itn < total;
        if (more) { cvt_decode(tb, dlo, dhi, itn, nxt); cvt_load(nxt, tid, R); }
#pragma unroll
        for (int i = 0; i < 4; ++i) {
            const int task = wid * 4 + i, nl = (task & 7) * 8 + (lane >> 3), ch = (task >> 3) * 8 + (lane & 7);
            const LAS float* sp = tile + (8 * ch) * 65 + nl;
            u32x4 o; o.x = cvt_pk_bf16(sp[0], sp[65]); o.y = cvt_pk_bf16(sp[2 * 65], sp[3 * 65]); o.z = cvt_pk_bf16(sp[4 * 65], sp[5 * 65]); o.w = cvt_pk_bf16(sp[6 * 65], sp[7 * 65]);
            *(u32x4*)(cur.dst + (size_t)(cur.nb * 64 + nl) * cur.K + cur.k0 + 8 * ch) = o;
        }
        __syncthreads();
        if (!more) break;
        ++j; it = itn; cur = nxt;
    }
#undef CVT_ITEM
}

template <bool COMBINE, bool FINAL>
__device__ __forceinline__ void norm_phase(const float* xsrc, float* xbuf, const bf16_t* yc, const float* g, bf16_t* h, float* outf, int tid, int bid, int nblk) {
    const int lane = tid & 63, wave = tid >> 6, nw = 8;
    f32x4 gv[4];
#pragma unroll
    for (int j = 0; j < 4; ++j) gv[j] = *(const f32x4*)(g + 4 * lane + 256 * j);
    for (int row = bid * nw + wave; row < T; row += nblk * nw) {
        f32x4 v[4]; float ss = 0.f;
#pragma unroll
        for (int j = 0; j < 4; ++j) {
            v[j] = *(const f32x4*)(xsrc + (size_t)row * D + 4 * lane + 256 * j);
            if (COMBINE) { v[j] += load4bf(yc + (size_t)(2 * row) * D + 4 * lane + 256 * j); v[j] += load4bf(yc + (size_t)(2 * row + 1) * D + 4 * lane + 256 * j); }
            ss += (v[j][0] * v[j][0] + v[j][1] * v[j][1]) + (v[j][2] * v[j][2] + v[j][3] * v[j][3]);
        }
        const float rstd = rsqrtf(wave_sum(ss) * (1.0f / D) + RMS_EPS);
#pragma unroll
        for (int j = 0; j < 4; ++j) {
            if (COMBINE && !FINAL) *(f32x4*)(xbuf + (size_t)row * D + 4 * lane + 256 * j) = v[j];
            const f32x4 o = v[j] * rstd * gv[j];
            if (FINAL) *(f32x4*)(outf + (size_t)row * D + 4 * lane + 256 * j) = o;
            else store4bf(h + (size_t)row * D + 4 * lane + 256 * j, o);
        }
    }
}

constexpr int RING_BYTES = 131072;
constexpr int LDSCTL_OFF = RING_BYTES, MISC_OFF = LDSCTL_OFF + 320;
constexpr int MOE_OFF = LDSCTL_OFF + 1024;
constexpr int RT_LOG = LDSCTL_OFF + 2048;
constexpr int RT_HIST = RT_LOG + 64 * 40 * 4;
constexpr int LDS_BYTES = 147456;
static_assert(RT_HIST + 256 <= LDS_BYTES, "LDS map");
__device__ __forceinline__ void router_phase(const float* xbuf, const float* g, const float* wg, const float* bg, const float* wr, const float* br,
                                             bf16_t* h2, unsigned* cnt, int* slot_tok, float* slot_w, int* slot_asg, LAS unsigned char* lds, int tid, int bid, int nblk) {
    const int lane = tid & 63, wid = tid >> 6, kk = lane & 15, rg = lane >> 4;
    if (bid == 0) for (int i = tid; i < D / 2; i += 512) ((unsigned*)(h2 + (size_t)T * D))[i] = 0u;
    for (int idx = tid; idx < 8192; idx += 512) {
        const int k = idx >> 3, q = idx & 7, kk_ = (k & 63) >> 2, e = k & 3, c = k >> 6;
        *(LAS f32x4*)(lds + q * 16384 + c * 1024 + e * 256 + kk_ * 16) = *(const f32x4*)(wr + (size_t)k * NE + 4 * q);
    }
    LAS float* logit = (LAS float*)(lds + RT_LOG); LAS int* hist = (LAS int*)(lds + RT_HIST); LAS int* base = hist + 32;
    __syncthreads();
    for (int rb = bid; rb < T / 64; rb += nblk) {
        const int rl0 = wid * 8 + rg, row0 = rb * 64 + rl0;
        const float* x0 = xbuf + (size_t)row0 * D + 4 * kk; const float* x1 = x0 + 4 * D;
        float a0[36], a1[36];
#pragma unroll
        for (int i = 0; i < 36; ++i) { a0[i] = 0.f; a1[i] = 0.f; }
        float ss0 = 0.f, ss1 = 0.f;
        f32x4 nxa = *(const f32x4*)x0, nxb = *(const f32x4*)x1, ngg = *(const f32x4*)(g + 4 * kk);
        f32x4 nwg[4];
#pragma unroll
        for (int e = 0; e < 4; ++e) nwg[e] = *(const f32x4*)(wg + (size_t)(4 * kk + e) * NG);
#pragma unroll 1
        for (int c = 0; c < 16; ++c) {
            f32x4 xa = nxa, xb = nxb; const f32x4 gg = ngg; f32x4 wgv[4];
#pragma unroll
            for (int e = 0; e < 4; ++e) wgv[e] = nwg[e];
            const int cn = c < 15 ? c + 1 : c;
            nxa = *(const f32x4*)(x0 + 64 * cn); nxb = *(const f32x4*)(x1 + 64 * cn); ngg = *(const f32x4*)(g + 4 * kk + 64 * cn);
#pragma unroll
            for (int e = 0; e < 4; ++e) nwg[e] = *(const f32x4*)(wg + (size_t)(4 * kk + e + 64 * cn) * NG);
            ss0 += (xa[0] * xa[0] + xa[1] * xa[1]) + (xa[2] * xa[2] + xa[3] * xa[3]);
            ss1 += (xb[0] * xb[0] + xb[1] * xb[1]) + (xb[2] * xb[2] + xb[3] * xb[3]);
            xa *= gg; xb *= gg;
            const LAS unsigned char* wl = lds + c * 1024 + kk * 16;
#pragma unroll
            for (int e = 0; e < 4; ++e) {
#pragma unroll
                for (int i = 0; i < 4; ++i) { a0[i] += xa[e] * wgv[e][i]; a1[i] += xb[e] * wgv[e][i]; }
#pragma unroll
                for (int q = 0; q < 8; ++q) { const f32x4 wv = *(const LAS f32x4*)(wl + q * 16384 + e * 256);
#pragma unroll
                    for (int i = 0; i < 4; ++i) { a0[4 + 4 * q + i] += xa[e] * wv[i]; a1[4 + 4 * q + i] += xb[e] * wv[i]; } }
            }
        }
#pragma unroll
        for (int o = 1; o < 16; o <<= 1) {
            ss0 += __shfl_xor(ss0, o); ss1 += __shfl_xor(ss1, o);
#pragma unroll
            for (int i = 0; i < 36; ++i) { a0[i] += __shfl_xor(a0[i], o); a1[i] += __shfl_xor(a1[i], o); }
        }
        const float rstd0 = rsqrtf(ss0 * (1.0f / D) + RMS_EPS), rstd1 = rsqrtf(ss1 * (1.0f / D) + RMS_EPS);
        if (kk == 0) {
#pragma unroll
            for (int i = 0; i < 36; ++i) { const float b = i < 4 ? bg[i] : br[i - 4]; logit[rl0 * 40 + i] = a0[i] * rstd0 + b; logit[(rl0 + 4) * 40 + i] = a1[i] * rstd1 + b; }
        }
#pragma unroll
        for (int cb = 0; cb < 16; cb += 4) {
            f32x4 xa[4], xb[4], gg[4];
#pragma unroll
            for (int j = 0; j < 4; ++j) { xa[j] = *(const f32x4*)(x0 + 64 * (cb + j)); xb[j] = *(const f32x4*)(x1 + 64 * (cb + j)); gg[j] = *(const f32x4*)(g + 4 * kk + 64 * (cb + j)); }
#pragma unroll
            for (int j = 0; j < 4; ++j) { store4bf(h2 + (size_t)row0 * D + 4 * kk + 64 * (cb + j), xa[j] * gg[j] * rstd0); store4bf(h2 + (size_t)(row0 + 4) * D + 4 * kk + 64 * (cb + j), xb[j] * gg[j] * rstd1); }
        }
        if (tid < 32) hist[tid] = 0;
        asm volatile("s_waitcnt lgkmcnt(0)" ::: "memory"); __syncthreads();
        int e0 = 0, e1 = 0, lr0 = 0, lr1 = 0; float w0 = 0.f, w1 = 0.f;
        if (tid < 64) {
            const LAS float* lp = logit + tid * 40;
            int gi = 0; float gm = lp[0];
#pragma unroll
            for (int i = 1; i < NG; ++i) { const float v = lp[i]; if (v > gm) { gm = v; gi = i; } }
            float gs = 0.f;
#pragma unroll
            for (int i = 0; i < NG; ++i) gs += __expf(lp[i] - gm);
            const float gp = 1.0f / gs;
            const LAS float* ep = lp + 4 + gi * EPG;
            int i0 = 0; float m0 = ep[0];
#pragma unroll
            for (int i = 1; i < EPG; ++i) { const float v = ep[i]; if (v > m0) { m0 = v; i0 = i; } }
            int i1 = -1; float m1 = -3.0e38f;
#pragma unroll
            for (int i = 0; i < EPG; ++i) { const float v = ep[i]; if (i != i0 && v > m1) { m1 = v; i1 = i; } }
            const float ex = __expf(m1 - m0); w0 = gp / (1.0f + ex); w1 = gp * ex / (1.0f + ex);
            e0 = gi * EPG + i0; e1 = gi * EPG + i1;
            lr0 = __hip_atomic_fetch_add((int*)(hist + e0), 1, __ATOMIC_RELAXED, __HIP_MEMORY_SCOPE_WORKGROUP);
            lr1 = __hip_atomic_fetch_add((int*)(hist + e1), 1, __ATOMIC_RELAXED, __HIP_MEMORY_SCOPE_WORKGROUP);
        }
        asm volatile("s_waitcnt lgkmcnt(0)" ::: "memory"); __syncthreads();
        if (tid < 32) { const int n = hist[tid]; base[tid] = n > 0 ? (int)atomicAdd(cnt + tid, (unsigned)n) : 0; }
        asm volatile("s_waitcnt vmcnt(0) lgkmcnt(0)" ::: "memory"); __syncthreads();
        if (tid < 64) {
            const int row = rb * 64 + tid, s0 = e0 * CAP + base[e0] + lr0, s1 = e1 * CAP + base[e1] + lr1;
            slot_tok[s0] = row; slot_w[s0] = w0; slot_asg[s0] = 2 * row;
            slot_tok[s1] = row; slot_w[s1] = w1; slot_asg[s1] = 2 * row + 1;
        }
        __syncthreads();
    }
}

__device__ __forceinline__ void midA_phase(const bf16_t* QA, bf16_t* BA, const float* cw  , int bid, int nblk) {
    const int nthr = blockDim.x;
    for (int idx = bid * nthr + threadIdx.x; idx < T * (D / 8); idx += nblk * nthr) {
        const int t = idx >> 7, c = (idx & 127) * 8, s = t & (SEQ - 1);
        const u32x4 z = {0u, 0u, 0u, 0u};
        const u32x4 q1 = *(const u32x4*)(QA + (size_t)t * D + c);
        u32x4 q0 = *(const u32x4*)(QA + (size_t)(s > 0 ? t - 1 : t) * D + c);
        u32x4 q2 = *(const u32x4*)(QA + (size_t)(s < SEQ - 1 ? t + 1 : t) * D + c);
        q0 = s > 0 ? q0 : z; q2 = s < SEQ - 1 ? q2 : z;
        const u32x4 bb = *(const u32x4*)(BA + (size_t)t * D + c);
        u32x4 o;
#pragma unroll
        for (int j = 0; j < 4; ++j) {
            const int c0 = c + 2 * j;
            const float lo = bf_lo(bb[j]) * (cw[c0] * bf_lo(q0[j]) + cw[D + c0] * bf_lo(q1[j]) + cw[2 * D + c0] * bf_lo(q2[j]));
            const float hi = bf_hi(bb[j]) * (cw[c0 + 1] * bf_hi(q0[j]) + cw[D + c0 + 1] * bf_hi(q1[j]) + cw[2 * D + c0 + 1] * bf_hi(q2[j]));
            o[j] = cvt_pk_bf16(lo, hi);
        }
        *(u32x4*)(BA + (size_t)t * D + c) = o;
    }
}
__device__ __forceinline__ void midB_conv_phase(const bf16_t* ZB, bf16_t* CB, const float* cw  , int bid, int nblk) {
    for (int cp = threadIdx.x; cp < D / 2; cp += blockDim.x) {
        f32x2 w[31];
#pragma unroll
        for (int j = 0; j < 31; ++j) w[j] = *(const f32x2*)(cw + j * D + 2 * cp);
        for (int tg = bid; tg < T / 16; tg += nblk) {
            const int t0 = tg * 16, s0 = t0 & (SEQ - 1);
            f32x2 acc[16];
#pragma unroll
            for (int o = 0; o < 16; ++o) acc[o] = (f32x2){0.f, 0.f};
#pragma unroll
            for (int i = 0; i < 46; ++i) {
                const int s = s0 - 15 + i;
                const bool ok = (s >= 0 && s < SEQ);
                unsigned xv = *(const unsigned*)(ZB + (size_t)(ok ? t0 - 15 + i : t0) * D + 2 * cp);
                xv = ok ? xv : 0u;
                const f32x2 x = {bf_lo(xv), bf_hi(xv)};
#pragma unroll
                for (int o = 0; o < 16; ++o) { const int j = i - o; if (j >= 0 && j < 31) acc[o] += w[j] * x; }
            }
#pragma unroll
            for (int o = 0; o < 16; ++o) *(unsigned*)(CB + (size_t)(t0 + o) * D + 2 * cp) = cvt_pk_bf16(acc[o][0], acc[o][1]);
        }
    }
}
__device__ __forceinline__ void row16_load(const bf16_t* rowp, int lane, float (&x)[16]) {
    const u32x4 a = *(const u32x4*)(rowp + 8 * lane), b = *(const u32x4*)(rowp + 512 + 8 * lane);
#pragma unroll
    for (int j = 0; j < 4; ++j) { x[2 * j] = bf_lo(a[j]); x[2 * j + 1] = bf_hi(a[j]); x[8 + 2 * j] = bf_lo(b[j]); x[8 + 2 * j + 1] = bf_hi(b[j]); }
}
__device__ __forceinline__ void row16_stats(const float (&x)[16], float& mean, float& rstd) {
    float s = 0.f;
#pragma unroll
    for (int j = 0; j < 16; ++j) s += x[j];
    mean = wave_sum(s) * (1.0f / D);
    float q = 0.f;
#pragma unroll
    for (int j = 0; j < 16; ++j) { const float d = x[j] - mean; q += d * d; }
    rstd = rsqrtf(wave_sum(q) * (1.0f / D) + LN_EPS);
}
__device__ __forceinline__ void midB_ln_phase(bf16_t* CB, const float* g, const float* b, int bid, int nblk) {
    const int lane = threadIdx.x & 63, wave = threadIdx.x >> 6, nw = blockDim.x >> 6;
    float gg[16], bb[16];
#pragma unroll
    for (int j = 0; j < 8; ++j) { gg[j] = g[8 * lane + j]; gg[8 + j] = g[512 + 8 * lane + j]; bb[j] = b[8 * lane + j]; bb[8 + j] = b[512 + 8 * lane + j]; }
    for (int row = bid * nw + wave; row < T; row += nblk * nw) {
        float x[16], mean, rstd; row16_load(CB + (size_t)row * D, lane, x); row16_stats(x, mean, rstd);
        u32x4 o0, o1;
#pragma unroll
        for (int j = 0; j < 4; ++j) {
            o0[j] = cvt_pk_bf16(siluf_((x[2 * j] - mean) * rstd * gg[2 * j] + bb[2 * j]), siluf_((x[2 * j + 1] - mean) * rstd * gg[2 * j + 1] + bb[2 * j + 1]));
            o1[j] = cvt_pk_bf16(siluf_((x[8 + 2 * j] - mean) * rstd * gg[8 + 2 * j] + bb[8 + 2 * j]), siluf_((x[8 + 2 * j + 1] - mean) * rstd * gg[8 + 2 * j + 1] + bb[8 + 2 * j + 1]));
        }
        *(u32x4*)(CB + (size_t)row * D + 8 * lane) = o0; *(u32x4*)(CB + (size_t)row * D + 512 + 8 * lane) = o1;
    }
}
__device__ __forceinline__ void midC_stats_phase(const bf16_t* V, float* stat, int bid, int nblk) {
    const int lane = threadIdx.x & 63, wave = threadIdx.x >> 6, nw = blockDim.x >> 6;
    for (int row = bid * nw + wave; row < T; row += nblk * nw) {
        float x[16], mean, rstd; row16_load(V + (size_t)row * D, lane, x); row16_stats(x, mean, rstd);
        if (lane == 0) *(f32x2*)(stat + 2 * row) = (f32x2){mean, rstd};
    }
}
#ifndef PROBE_MID
#define PROBE_MID 0
#endif
constexpr int MC_LD = 272;
constexpr int MID_STAT = 0, MID_SA = 1024, MID_SB = 1024 + 64 * MC_LD, MID_LDS = MID_SB + 128 * MC_LD;
__device__ __forceinline__ void mid_phase(rsrc_t wsr, unsigned char* wsb, const bf16_t* V,
                                          const float* cwa  , const float* cwb  , const float* lnbg, const float* lnbb, const float* lncg, const float* lncb,
                                          const float* Ws  , const float* bs  , const float* rowsum  , LAS unsigned char* lds, int tid, int bid, int nblk, unsigned long long& mpt) {
    const int lane = tid & 63, wid = __builtin_amdgcn_readfirstlane(tid >> 6), fr = lane & 15, fq = lane >> 4;
    unsigned long long mp0 = 0ull; (void)mp0;
#define MPB(j) do { if ((PROBE_MID >> (j)) & 1) { __syncthreads(); mp0 = __builtin_amdgcn_s_memrealtime(); } } while (0)
#define MPE(j) do { if ((PROBE_MID >> (j)) & 1) { asm volatile("s_waitcnt vmcnt(0) lgkmcnt(0)" ::: "memory"); __syncthreads(); mpt += __builtin_amdgcn_s_memrealtime() - mp0; } } while (0)
    LAS float* statL = (LAS float*)(lds + MID_STAT); LAS unsigned char* SA = lds + MID_SA; LAS unsigned char* SB = lds + MID_SB;
    const u32x4 z4 = {0u, 0u, 0u, 0u};
    for (int tile = bid; tile < T / 64; tile += nblk) {
        const int t0 = tile * 64, ch0 = (tile >> 1) * 128, half = tile & 1;
        const bf16_t* QA = (const bf16_t*)(wsb + WS_QA); bf16_t* BA = (bf16_t*)(wsb + WS_BA);
        MPB(0);
        {
            int tz = tid; asm volatile("" : "+v"(tz));
            const int c = (tz & 127) * 8, r0 = tz >> 7;
            float w0[8], w1[8], w2[8];
#pragma unroll
            for (int j = 0; j < 8; ++j) { w0[j] = cwa[c + j]; w1[j] = cwa[D + c + j]; w2[j] = cwa[2 * D + c + j]; }
#pragma unroll 1
            for (int k4 = 0; k4 < 16; k4 += 4) {
                u32x4 q0[4], q1[4], q2[4], bb[4];
#pragma unroll
                for (int u = 0; u < 4; ++u) {
                    const int t = t0 + r0 + 4 * (k4 + u), sq = t & (SEQ - 1);
                    q1[u] = *(const u32x4*)(QA + (size_t)t * D + c);
                    q0[u] = *(const u32x4*)(QA + (size_t)(sq > 0 ? t - 1 : t) * D + c);
                    q2[u] = *(const u32x4*)(QA + (size_t)(sq < SEQ - 1 ? t + 1 : t) * D + c);
                    bb[u] = *(const u32x4*)(BA + (size_t)t * D + c);
                }
#pragma unroll
                for (int u = 0; u < 4; ++u) {
                    const int t = t0 + r0 + 4 * (k4 + u), sq = t & (SEQ - 1);
                    const u32x4 a0 = sq > 0 ? q0[u] : z4, a2 = sq < SEQ - 1 ? q2[u] : z4;
                    u32x4 o;
#pragma unroll
                    for (int e = 0; e < 4; ++e) {
                        const float lo = bf_lo(bb[u][e]) * (w0[2 * e] * bf_lo(a0[e]) + w1[2 * e] * bf_lo(q1[u][e]) + w2[2 * e] * bf_lo(a2[e]));
                        const float hi = bf_hi(bb[u][e]) * (w0[2 * e + 1] * bf_hi(a0[e]) + w1[2 * e + 1] * bf_hi(q1[u][e]) + w2[2 * e + 1] * bf_hi(a2[e]));
                        o[e] = cvt_pk_bf16(lo, hi);
                    }
                    *(u32x4*)(BA + (size_t)t * D + c) = o;
                }
            }
        }
        MPE(0); MPB(1);
        {
            int cp = tid; asm volatile("" : "+v"(cp) :: "memory");
            f32x2 w[31];
#pragma unroll
            for (int j = 0; j < 31; ++j) w[j] = *(const f32x2*)(cwb + j * D + 2 * cp);
            const unsigned zrow0 = (unsigned)(t0 + 2 * ZPAD * (t0 >= SEQ ? 1 : 0));
            for (int g = 0; g < 4; ++g) {
                const unsigned sb = (unsigned)WS_ZB + (zrow0 + 16u * (unsigned)g) * (unsigned)(D * 2);
                f32x2 acc[16];
#pragma unroll
                for (int o = 0; o < 16; ++o) acc[o] = (f32x2){0.f, 0.f};
#pragma unroll
                for (int ib = 0; ib < 48; ib += 16) {
                    unsigned xv[16];
#pragma unroll
                    for (int q = 0; q < 16; ++q) if (ib + q < 46) xv[q] = __builtin_amdgcn_raw_buffer_load_b32(wsr, (unsigned)(4 * cp), sb + (unsigned)((ib + q) * D * 2), 0);
#pragma unroll
                    for (int q = 0; q < 16; ++q) if (ib + q < 46) {
                        const int i = ib + q; const f32x2 x = {bf_lo(xv[q]), bf_hi(xv[q])};
#pragma unroll
                        for (int o = 0; o < 16; ++o) { const int j = i - o; if (j >= 0 && j < 31) acc[o] += w[j] * x; }
                    }
                }
                const unsigned so = (unsigned)WS_CB + (unsigned)(t0 + 16 * g) * (unsigned)(D * 2);
#pragma unroll
                for (int o = 0; o < 16; ++o) __builtin_amdgcn_raw_buffer_store_b32(cvt_pk_bf16(acc[o][0], acc[o][1]), wsr, (unsigned)(4 * cp), so + (unsigned)(o * D * 2), 0);
            }
        }
        MPE(1); MPB(2);
        int lz = lane; asm volatile("" : "+v"(lz));
#pragma unroll 1
        for (int rq = 0; rq < 16; rq += 4) {
            float x[4][16];
#pragma unroll
            for (int j = 0; j < 4; ++j) row16_load(V + (size_t)(ch0 + wid * 16 + rq + j) * D, lz, x[j]);
#pragma unroll
            for (int j = 0; j < 4; ++j) { float mean, rstd; row16_stats(x[j], mean, rstd); if (lane == 0) { const int r = wid * 16 + rq + j; statL[2 * r] = mean; statL[2 * r + 1] = rstd; } }
        }
        asm volatile("s_waitcnt vmcnt(0) lgkmcnt(0)" ::: "memory"); __syncthreads();
        {
            int ld_ = lane; asm volatile("" : "+v"(ld_));
            float gg[16], bb[16];
#pragma unroll
            for (int j = 0; j < 8; ++j) { gg[j] = lnbg[8 * ld_ + j]; gg[8 + j] = lnbg[512 + 8 * ld_ + j]; bb[j] = lnbb[8 * ld_ + j]; bb[8 + j] = lnbb[512 + 8 * ld_ + j]; }
#pragma unroll 1
            for (int rq = 0; rq < 8; rq += 4) {
                float x[4][16];
#pragma unroll
                for (int j = 0; j < 4; ++j) { const u32x4 a = __builtin_amdgcn_raw_buffer_load_b128(wsr, (unsigned)(lane * 16), (unsigned)WS_CB + (unsigned)(t0 + wid * 8 + rq + j) * (unsigned)(D * 2), 0),
                                                              b = __builtin_amdgcn_raw_buffer_load_b128(wsr, (unsigned)(lane * 16 + 1024), (unsigned)WS_CB + (unsigned)(t0 + wid * 8 + rq + j) * (unsigned)(D * 2), 0);
#pragma unroll
                    for (int e = 0; e < 4; ++e) { x[j][2 * e] = bf_lo(a[e]); x[j][2 * e + 1] = bf_hi(a[e]); x[j][8 + 2 * e] = bf_lo(b[e]); x[j][8 + 2 * e + 1] = bf_hi(b[e]); } }
#pragma unroll
                for (int j = 0; j < 4; ++j) {
                    float mean, rstd; row16_stats(x[j], mean, rstd);
                    u32x4 o0, o1;
#pragma unroll
                    for (int e = 0; e < 4; ++e) {
                        o0[e] = cvt_pk_bf16(siluf_((x[j][2 * e] - mean) * rstd * gg[2 * e] + bb[2 * e]), siluf_((x[j][2 * e + 1] - mean) * rstd * gg[2 * e + 1] + bb[2 * e + 1]));
                        o1[e] = cvt_pk_bf16(siluf_((x[j][8 + 2 * e] - mean) * rstd * gg[8 + 2 * e] + bb[8 + 2 * e]), siluf_((x[j][8 + 2 * e + 1] - mean) * rstd * gg[8 + 2 * e + 1] + bb[8 + 2 * e + 1]));
                    }
                    const unsigned so = (unsigned)WS_CB + (unsigned)(t0 + wid * 8 + rq + j) * (unsigned)(D * 2);
                    __builtin_amdgcn_raw_buffer_store_b128(o0, wsr, (unsigned)(lane * 16), so, 0); __builtin_amdgcn_raw_buffer_store_b128(o1, wsr, (unsigned)(lane * 16 + 1024), so, 0);
                }
            }
        }
        MPE(2); MPB(3);
        {
            const int wr = wid >> 2, wc = wid & 3;
            int te = tid; asm volatile("" : "+v"(te));
            f32x4 ra[2][2]; u32x4 rv[2][2]; u32x2 ru[2][2]; f32x4 rg[2], rbe[2]; float rs[2], rbi[2];
#define MID_ISSUE(h) do { \
_Pragma("unroll") \
                for (int i = 0; i < 2; ++i) { const int idx = te + 512 * i, pr = idx >> 4, q8 = idx & 15; const float* sp = Ws + ((size_t)(h) * 128 + half * 64 + pr) * 128 + q8 * 8; ra[i][0] = *(const f32x4*)sp; ra[i][1] = *(const f32x4*)(sp + 4); } \
_Pragma("unroll") \
                for (int i = 0; i < 2; ++i) { const int idx = te + 512 * i, qp = idx & 63, c8 = idx >> 6; const bf16_t* vp = V + (size_t)(ch0 + 2 * qp) * D + (h) * 128 + c8 * 8; rv[i][0] = *(const u32x4*)vp; rv[i][1] = *(const u32x4*)(vp + D); } \
_Pragma("unroll") \
                for (int m = 0; m < 2; ++m) { rs[m] = rowsum[(h) * 128 + half * 64 + wr * 32 + m * 16 + fr]; rbi[m] = bs[(h) * 128 + half * 64 + wr * 32 + m * 16 + fr]; \
_Pragma("unroll") \
                    for (int nn = 0; nn < 2; ++nn) ru[m][nn] = __builtin_amdgcn_raw_buffer_load_b64(wsr, (unsigned)(fr * (D * 2) + fq * 8), (unsigned)WS_U + (unsigned)(t0 + wr * 32 + m * 16) * (unsigned)(D * 2) + (unsigned)((h) * 128 + wc * 32 + nn * 16) * 2u, 0); } \
_Pragma("unroll") \
                for (int nn = 0; nn < 2; ++nn) { rg[nn] = *(const f32x4*)(lncg + (h) * 128 + wc * 32 + nn * 16 + 4 * fq); rbe[nn] = *(const f32x4*)(lncb + (h) * 128 + wc * 32 + nn * 16 + 4 * fq); } \
             } while (0)
            MID_ISSUE(0);
#pragma unroll 1
            for (int h = 0; h < NHC; ++h) {
#pragma unroll
                for (int i = 0; i < 2; ++i) { const int idx = te + 512 * i, pr = idx >> 4, q8 = idx & 15;
                    u32x4 o; o.x = cvt_pk_bf16(ra[i][0][0], ra[i][0][1]); o.y = cvt_pk_bf16(ra[i][0][2], ra[i][0][3]); o.z = cvt_pk_bf16(ra[i][1][0], ra[i][1][1]); o.w = cvt_pk_bf16(ra[i][1][2], ra[i][1][3]);
                    *(LAS u32x4*)(SA + pr * MC_LD + q8 * 16) = o; }
#pragma unroll
                for (int i = 0; i < 2; ++i) { const int idx = te + 512 * i, qp = idx & 63, c8 = idx >> 6;
                    const f32x4 st = *(const LAS f32x4*)(statL + 4 * qp);
#pragma unroll
                    for (int j = 0; j < 4; ++j) {
                        *(LAS unsigned*)(SB + (c8 * 8 + 2 * j) * MC_LD + qp * 4) = cvt_pk_bf16((bf_lo(rv[i][0][j]) - st[0]) * st[1], (bf_lo(rv[i][1][j]) - st[2]) * st[3]);
                        *(LAS unsigned*)(SB + (c8 * 8 + 2 * j + 1) * MC_LD + qp * 4) = cvt_pk_bf16((bf_hi(rv[i][0][j]) - st[0]) * st[1], (bf_hi(rv[i][1][j]) - st[2]) * st[3]);
                    } }
                u32x2 uc[2][2]; f32x4 gc[2], bc[2]; float sc[2], bic[2];
#pragma unroll
                for (int m = 0; m < 2; ++m) { sc[m] = rs[m]; bic[m] = rbi[m]; gc[m] = rg[m]; bc[m] = rbe[m];
#pragma unroll
                    for (int nn = 0; nn < 2; ++nn) uc[m][nn] = ru[m][nn]; }
                asm volatile("s_waitcnt lgkmcnt(0)" ::: "memory"); __syncthreads();
                if (h + 1 < NHC) MID_ISSUE(h + 1);
                f32x4 acc[2][2];
#pragma unroll
                for (int m = 0; m < 2; ++m)
#pragma unroll
                    for (int nn = 0; nn < 2; ++nn) acc[m][nn] = (f32x4){0.f, 0.f, 0.f, 0.f};
#pragma unroll
                for (int ks = 0; ks < 4; ++ks) {
                    bf16x8 a[2], b[2];
#pragma unroll
                    for (int m = 0; m < 2; ++m) a[m] = *(const LAS bf16x8*)(SA + (wr * 32 + m * 16 + fr) * MC_LD + ks * 64 + fq * 16);
#pragma unroll
                    for (int nn = 0; nn < 2; ++nn) b[nn] = *(const LAS bf16x8*)(SB + (wc * 32 + nn * 16 + fr) * MC_LD + ks * 64 + fq * 16);
#pragma unroll
                    for (int m = 0; m < 2; ++m)
#pragma unroll
                        for (int nn = 0; nn < 2; ++nn) acc[m][nn] = __builtin_amdgcn_mfma_f32_16x16x32_bf16(b[nn], a[m], acc[m][nn], 0, 0, 0);
                }
#pragma unroll
                for (int m = 0; m < 2; ++m)
#pragma unroll
                    for (int nn = 0; nn < 2; ++nn) {
                        const f32x4 uu = {bf_lo(uc[m][nn].x), bf_hi(uc[m][nn].x), bf_lo(uc[m][nn].y), bf_hi(uc[m][nn].y)};
                        const f32x4 o = gc[nn] * acc[m][nn] + (bc[nn] * sc[m] + bic[m]);
                        bst4bf(wsr, (unsigned)(fr * (D * 2) + fq * 8), (unsigned)WS_U + (unsigned)(t0 + wr * 32 + m * 16) * (unsigned)(D * 2) + (unsigned)(h * 128 + wc * 32 + nn * 16) * 2u, uu * o);
                    }
                asm volatile("s_waitcnt lgkmcnt(0)" ::: "memory"); __syncthreads();
            }
        }
        MPE(3);
    }
}

namespace pg8 {
constexpr int BM = 256, BK = 64, HALF = 128, HTB = HALF * BK * 2  , STAGE_BYTES = 8 * HTB, NXCD = 8, WGM = 8;
__device__ __forceinline__ int lds_byte(int r, int c) { const int st = (r >> 4) * 2 + (c >> 5), rr = r & 15, cc = c & 31, ob = rr * 64 + cc * 2; return st * 1024 + (ob ^ (((ob >> 9) & 1) << 5)); }
__device__ __forceinline__ void stage_rc(int b, int& R, int& C) { const int st = b / 1024, sb = b % 1024, swz = sb ^ (((sb >> 9) & 1) << 5); R = (st >> 1) * 16 + swz / 64; C = (st & 1) * 32 + (swz % 64) / 2; }
struct Unit { int pm, pn, e, it, ne; };
struct StaticOrder {
    int nM, nN, nwg, G, c;
    __device__ __forceinline__ void init(int M, int N, int G_, int c_) { nM = M / BM; nN = N / BM; nwg = nM * nN; G = G_; c = c_; }
    __device__ __forceinline__ bool next(int i, int& pm, int& pn) const {
        const long L = (long)i * G + c; if (L >= nwg) return false;
        int wgid = (int)L; { const int q = nwg / NXCD, r = nwg % NXCD, xcd = wgid % NXCD, off = wgid / NXCD; wgid = (xcd < r ? xcd * (q + 1) : r * (q + 1) + (xcd - r) * q) + off; }
        const int nig = WGM * nN, gid = wgid / nig, fm = gid * WGM, gsz = (nM - fm) < WGM ? (nM - fm) : WGM;
        pm = fm + ((wgid % nig) % gsz); pn = (wgid % nig) / gsz; return true;
    }
};
template <int NGRP, class Epi> __device__ __forceinline__ void run_epi(const Epi& E, f32x4 (&acc)[2][2][4][2], const Unit& u, int wr, int wc, int fr, int fq) {
#pragma unroll
    for (int ai = 0; ai < 2; ++ai)
#pragma unroll
        for (int mb = 0; mb < 4; mb += NGRP) {
            typename Epi::Regs R[NGRP][2];
#pragma unroll
            for (int g = 0; g < NGRP; ++g)
#pragma unroll
                for (int bj = 0; bj < 2; ++bj) E.pre(u, u.pm * BM + ai * HALF + wr * 64 + (mb + g) * 16, u.pn * BM + bj * HALF + wc * 32, fr, fq, R[g][bj]);
#pragma unroll
            for (int g = 0; g < NGRP; ++g)
#pragma unroll
                for (int bj = 0; bj < 2; ++bj) E.post(u, u.pm * BM + ai * HALF + wr * 64 + (mb + g) * 16, u.pn * BM + bj * HALF + wc * 32, fr, fq, R[g][bj], acc[ai][bj][mb + g][0], acc[ai][bj][mb + g][1]);
            asm volatile("" ::: "memory");
        }
}
template <class Prob, bool ALIGN_EPI>
__device__ __forceinline__ void gemm_phase(LAS unsigned char* lds, const Prob& P, int tid) {
    const int wid = __builtin_amdgcn_readfirstlane(tid >> 6), lane = tid & 63, wr = wid >> 2, wc = wid & 3, fr = lane & 15, fq = lane >> 4;
    const int K = P.K, nt = K / BK;
    unsigned voffA[2], voffB[2]; int sR[2], sC[2];
#pragma unroll
    for (int i = 0; i < 2; ++i) { stage_rc(tid * 16 + i * 8192, sR[i], sC[i]); voffA[i] = (unsigned)(sR[i] * K + sC[i]) * 2u; voffB[i] = voffA[i]; }
    const size_t kstep = (size_t)(BK * 2);
    const size_t hstep = (size_t)HALF * K * 2;
    const unsigned ldsw = (unsigned)wid * 1024u;
    const int aoff = lds_byte(wr * 64 + fr, fq * 8), boff = lds_byte(wc * 32 + fr, fq * 8);
#define PG8_SA(b, h) (((b) * 2 + (h)) * HTB)
#define PG8_SB(b, h) ((4 + (b) * 2 + (h)) * HTB)
#define PG8_STAGE(bufoff, gbase, voff) do { _Pragma("unroll") for (int _i = 0; _i < 2; ++_i) \
        __builtin_amdgcn_global_load_lds((const unsigned*)((const char*)(gbase) + (voff)[_i]), (LAS unsigned*)(lds + (bufoff) + ldsw + _i * 8192), 16, 0, 0); } while (0)
#define PG8_STAGE_A(bufoff, ptr, h, go) do { if constexpr (Prob::GATHER) PG8_STAGE(bufoff, ptr, (go)[h]); else PG8_STAGE(bufoff, (ptr) + (h) * hstep, voffA); } while (0)
#define PG8_LDA(dst, b, h) do { _Pragma("unroll") for (int m = 0; m < 4; ++m) _Pragma("unroll") for (int k = 0; k < 2; ++k) dst[m][k] = *(const LAS bf16x8*)(lds + PG8_SA(b, h) + aoff + m * 2048 + k * 1024); } while (0)
#define PG8_LDB(dst, b, h) do { _Pragma("unroll") for (int n = 0; n < 2; ++n) _Pragma("unroll") for (int k = 0; k < 2; ++k) dst[n][k] = *(const LAS bf16x8*)(lds + PG8_SB(b, h) + boff + n * 2048 + k * 1024); } while (0)
#define PG8_MMA(ai, bj, At, Bt) do { __builtin_amdgcn_s_setprio(1); _Pragma("unroll") for (int m = 0; m < 4; ++m) _Pragma("unroll") for (int n = 0; n < 2; ++n) _Pragma("unroll") for (int k = 0; k < 2; ++k) \
        acc[ai][bj][m][n] = __builtin_amdgcn_mfma_f32_16x16x32_bf16(Bt[n][k], At[m][k], acc[ai][bj][m][n], 0, 0, 0); __builtin_amdgcn_s_setprio(0); } while (0)
#define PG8_WAIT_V(n) asm volatile("s_waitcnt vmcnt(" #n ")" ::: "memory")
#define PG8_WAIT_L(n) asm volatile("s_waitcnt lgkmcnt(" #n ")" ::: "memory")
#define PG8_BAR __builtin_amdgcn_s_barrier()
#define PG8_SCHED __builtin_amdgcn_sched_barrier(0)
    Unit cur, nxt; int ui = 0;
    if (!P.next(0, cur)) return;
    f32x4 acc[2][2][4][2];
#pragma unroll
    for (int a = 0; a < 2; ++a)
#pragma unroll
        for (int b = 0; b < 2; ++b)
#pragma unroll
            for (int m = 0; m < 4; ++m)
#pragma unroll
                for (int n = 0; n < 2; ++n) acc[a][b][m][n] = (f32x4){0.f, 0.f, 0.f, 0.f};
    bf16x8 At[4][2], B0[2][2], B1[2][2];
    const char* cA = P.abase(cur); const char* cB = P.bbase(cur);
    unsigned cgo[2][2] = {{0u, 0u}, {0u, 0u}}, ngo[2][2] = {{0u, 0u}, {0u, 0u}};
    if constexpr (Prob::GATHER) P.goffs(cur, sR, sC, cgo);
    PG8_STAGE(PG8_SB(0, 0), cB, voffB); PG8_STAGE(PG8_SB(0, 1), cB + hstep, voffB); PG8_STAGE_A(PG8_SA(0, 0), cA, 0, cgo); PG8_STAGE_A(PG8_SA(0, 1), cA, 1, cgo);
    if (wr == 1) PG8_BAR;
    PG8_WAIT_V(2); PG8_BAR;
    PG8_STAGE(PG8_SB(1, 0), cB + kstep, voffB); PG8_STAGE_A(PG8_SA(1, 0), cA + kstep, 0, cgo); PG8_STAGE(PG8_SB(1, 1), cB + hstep + kstep, voffB);
    PG8_WAIT_V(6); PG8_BAR;
    for (;;) {
        const bool has_next = P.next(ui + 1, nxt);
        const char* nA = has_next ? P.abase(nxt) : cA; const char* nB = has_next ? P.bbase(nxt) : cB;
        if constexpr (Prob::GATHER) {
            if (has_next) P.goffs(nxt, sR, sC, ngo);
            else {
#pragma unroll
                for (int h = 0; h < 2; ++h)
#pragma unroll
                    for (int i = 0; i < 2; ++i) ngo[h][i] = cgo[h][i]; }
        }
        for (int t = 0; t < nt; t += 2) {
            const bool last = (t == nt - 2);
            const char* a1 = cA + (size_t)(t + 1) * kstep;
            const char* a2 = last ? nA : cA + (size_t)(t + 2) * kstep; const char* b2 = last ? nB : cB + (size_t)(t + 2) * kstep;
            const char* a3 = a2 + kstep; const char* b3 = b2 + kstep;
            unsigned g2[2][2];
#pragma unroll
            for (int h = 0; h < 2; ++h)
#pragma unroll
                for (int i = 0; i < 2; ++i) g2[h][i] = last ? ngo[h][i] : cgo[h][i];
            PG8_LDB(B0, 0, 0); PG8_LDB(B1, 0, 1); PG8_SCHED; PG8_LDA(At, 0, 0); PG8_STAGE_A(PG8_SA(1, 1), a1, 1, cgo);
            PG8_WAIT_V(8); PG8_WAIT_L(0); PG8_BAR; PG8_MMA(0, 0, At, B0); PG8_MMA(0, 1, At, B1); PG8_BAR; PG8_SCHED;
            PG8_LDA(At, 0, 1); PG8_STAGE(PG8_SB(0, 0), b2, voffB); PG8_STAGE(PG8_SB(0, 1), b2 + hstep, voffB); PG8_STAGE_A(PG8_SA(0, 0), a2, 0, g2);
            PG8_WAIT_V(8); PG8_WAIT_L(0); PG8_BAR; PG8_MMA(1, 0, At, B0); PG8_MMA(1, 1, At, B1); PG8_BAR; PG8_SCHED;
            PG8_LDB(B0, 1, 0); PG8_LDB(B1, 1, 1); PG8_SCHED; PG8_LDA(At, 1, 0); PG8_STAGE_A(PG8_SA(0, 1), a2, 1, g2);
            PG8_WAIT_V(8); PG8_WAIT_L(0); PG8_BAR; PG8_MMA(0, 0, At, B0); PG8_MMA(0, 1, At, B1); PG8_BAR; PG8_SCHED;
            PG8_LDA(At, 1, 1); PG8_STAGE(PG8_SB(1, 0), b3, voffB); PG8_STAGE(PG8_SB(1, 1), b3 + hstep, voffB); PG8_STAGE_A(PG8_SA(1, 0), a3, 0, g2);
            PG8_WAIT_V(8); PG8_WAIT_L(0); PG8_BAR; PG8_MMA(1, 0, At, B0); PG8_MMA(1, 1, At, B1); PG8_BAR; PG8_SCHED;
        }
        if constexpr (ALIGN_EPI) { if (wr == 0) PG8_BAR; }
        P.epi(acc, cur, wr, wc, fr, fq);
        if (!has_next) break;
        if (!(Prob::CHAIN && P.chain(cur)))
#pragma unroll
        for (int a = 0; a < 2; ++a)
#pragma unroll
            for (int b = 0; b < 2; ++b)
#pragma unroll
                for (int m = 0; m < 4; ++m)
#pragma unroll
                    for (int n = 0; n < 2; ++n) acc[a][b][m][n] = (f32x4){0.f, 0.f, 0.f, 0.f};
        cur = nxt; cA = nA; cB = nB; ++ui;
        if constexpr (Prob::GATHER) {
#pragma unroll
            for (int h = 0; h < 2; ++h)
#pragma unroll
                for (int i = 0; i < 2; ++i) cgo[h][i] = ngo[h][i]; }
        if constexpr (ALIGN_EPI) { if (wr == 1) PG8_BAR; }
    }
    PG8_WAIT_V(0);
    if constexpr (!ALIGN_EPI) { if (wr == 0) PG8_BAR; }
    PG8_BAR;
#undef PG8_SA
#undef PG8_SB
#undef PG8_STAGE
#undef PG8_STAGE_A
#undef PG8_LDA
#undef PG8_LDB
#undef PG8_MMA
#undef PG8_WAIT_V
#undef PG8_WAIT_L
#undef PG8_BAR
#undef PG8_SCHED
}
}
using pg8::Unit;

constexpr size_t TSTEP_D = (size_t)256 * D * 2;
__device__ __forceinline__ int pcu(int cu) { return 32 * (cu >> 6) + 16 * ((cu >> 5) & 1); }
struct ProbInProj {
    static constexpr bool GATHER = false, CHAIN = false; __device__ __forceinline__ bool chain(const Unit&) const { return false; }
    const bf16_t* A; const bf16_t* Bt; int K; pg8::StaticOrder S; rsrc_t wsr;
    __device__ __forceinline__ bool next(int i, Unit& u) const { int pm, pn; if (!S.next(i, pm, pn)) return false; u.pm = pm; u.pn = pn; u.e = 0; u.it = 0; u.ne = 0; return true; }
    __device__ __forceinline__ const char* abase(const Unit& u) const { return (const char*)A + (size_t)u.pm * TSTEP_D; }
    __device__ __forceinline__ const char* bbase(const Unit& u) const { return (const char*)Bt + (size_t)u.pn * TSTEP_D; }
    __device__ __forceinline__ void goffs(const Unit&, const int (&)[2], const int (&)[2], unsigned (&)[2][2]) const {}
    struct Regs {};
    __device__ __forceinline__ void pre(const Unit&, int, int, int, int, Regs&) const {}
    __device__ __forceinline__ void post(const Unit&, int ru, int cu, int fr, int fq, const Regs&, f32x4 va, f32x4 vb) const {
        const unsigned v1 = (unsigned)(fr * (D * 2) + fq * 8), row1 = (unsigned)ru * (unsigned)(D * 2);
        if (cu < 2048) bst4bf(wsr, v1, (unsigned)WS_QA + row1 + (unsigned)pcu(cu) * 2u, va * vb);
        else if (cu < 3072) { const unsigned so = (unsigned)WS_BA + row1 + (unsigned)(cu - 2048) * 2u; bst4bf(wsr, v1, so, va); bst4bf(wsr, v1 + 32u, so, vb); }
        else if (cu < 5120) { const unsigned zr = (unsigned)(ru + ZPAD + 2 * ZPAD * (ru >= SEQ ? 1 : 0)) * (unsigned)(D * 2); bst4bf(wsr, v1, (unsigned)WS_ZB + zr + (unsigned)pcu(cu - 3072) * 2u, va * sig4(vb)); }
        else if (cu < 7168) { const int cc = cu - 5120; const unsigned so = (cc < 1024 ? (unsigned)WS_U + (unsigned)cc * 2u : (unsigned)WS_V + (unsigned)(cc - 1024) * 2u) + row1; bst4bf(wsr, v1, so, gelu4(va)); bst4bf(wsr, v1 + 32u, so, gelu4(vb)); }
        else { const unsigned v3 = (unsigned)(fr * (3 * D * 2) + fq * 8), so = (unsigned)WS_G + (unsigned)ru * (unsigned)(3 * D * 2) + (unsigned)(cu - 7168) * 2u; bst4bf(wsr, v3, so, sig4(va)); bst4bf(wsr, v3 + 32u, so, sig4(vb)); }
    }
    __device__ __forceinline__ void epi(f32x4 (&acc)[2][2][4][2], const Unit& u, int wr, int wc, int fr, int fq) const { pg8::run_epi<1>(*this, acc, u, wr, wc, fr, fq); }
};
struct ProbBranch {
    static constexpr bool GATHER = false, CHAIN = true;
    const unsigned char* ws; int K; pg8::StaticOrder S; rsrc_t wsr;
    __device__ __forceinline__ bool chain(const Unit& u) const { return u.e < 2; }
    __device__ __forceinline__ bool next(int i, Unit& u) const { int pm, pn; if (!S.next(i / 3, pm, pn)) return false; u.pm = pm; u.pn = pn; u.e = i % 3; u.it = 0; u.ne = 0; return true; }
    __device__ __forceinline__ const char* abase(const Unit& u) const { return (const char*)ws + WS_BA + (size_t)u.e * (WS_CB - WS_BA) + (size_t)u.pm * TSTEP_D; }
    __device__ __forceinline__ const char* bbase(const Unit& u) const { return (const char*)ws + WS_WA + (size_t)u.e * (WS_WB - WS_WA) + (size_t)u.pn * TSTEP_D; }
    __device__ __forceinline__ void goffs(const Unit&, const int (&)[2], const int (&)[2], unsigned (&)[2][2]) const {}
    struct Regs { u32x2 ga, gb, na, nb; };
    __device__ __forceinline__ void pre(const Unit& u, int ru, int cu, int fr, int fq, Regs& R) const {
        const unsigned v3 = (unsigned)(fr * (3 * D * 2) + fq * 8), sg = (unsigned)WS_G + (unsigned)ru * (unsigned)(3 * D * 2) + (unsigned)(u.e * D + cu) * 2u;
        R.ga = __builtin_amdgcn_raw_buffer_load_b64(wsr, v3, sg, 0); R.gb = __builtin_amdgcn_raw_buffer_load_b64(wsr, v3 + 32u, sg, 0);
        if (u.e < 2) { R.na = __builtin_amdgcn_raw_buffer_load_b64(wsr, v3, sg + (unsigned)(D * 2), 0); R.nb = __builtin_amdgcn_raw_buffer_load_b64(wsr, v3 + 32u, sg + (unsigned)(D * 2), 0); }
    }
    __device__ __forceinline__ void post(const Unit& u, int ru, int cu, int fr, int fq, const Regs& R, f32x4& va, f32x4& vb) const {
        const f32x4 ga = {bf_lo(R.ga.x), bf_hi(R.ga.x), bf_lo(R.ga.y), bf_hi(R.ga.y)}, gb = {bf_lo(R.gb.x), bf_hi(R.gb.x), bf_lo(R.gb.y), bf_hi(R.gb.y)};
        if (u.e < 2) {
            const f32x4 na = {bf_lo(R.na.x), bf_hi(R.na.x), bf_lo(R.na.y), bf_hi(R.na.y)}, nb = {bf_lo(R.nb.x), bf_hi(R.nb.x), bf_lo(R.nb.y), bf_hi(R.nb.y)};
#pragma unroll
            for (int j = 0; j < 4; ++j) { va[j] = va[j] * ga[j] * __builtin_amdgcn_rcpf(fmaxf(na[j], 1e-30f)); vb[j] = vb[j] * gb[j] * __builtin_amdgcn_rcpf(fmaxf(nb[j], 1e-30f)); }
        } else {
            const unsigned v1 = (unsigned)(fr * (D * 2) + fq * 8), so = (unsigned)WS_H + (unsigned)ru * (unsigned)(D * 2) + (unsigned)cu * 2u;
            bst4bf(wsr, v1, so, va * ga); bst4bf(wsr, v1 + 32u, so, vb * gb);
        }
    }
    __device__ __forceinline__ void epi(f32x4 (&acc)[2][2][4][2], const Unit& u, int wr, int wc, int fr, int fq) const { pg8::run_epi<2>(*this, acc, u, wr, wc, fr, fq); }
};
struct ProbWo {
    static constexpr bool GATHER = false, CHAIN = false; __device__ __forceinline__ bool chain(const Unit&) const { return false; }
    const bf16_t* A; const bf16_t* Bt; int K; pg8::StaticOrder S;
    rsrc_t xin, xout;
    __device__ __forceinline__ bool next(int i, Unit& u) const { int pm, pn; if (!S.next(i, pm, pn)) return false; u.pm = pm; u.pn = pn; u.e = 0; u.it = 0; u.ne = 0; return true; }
    __device__ __forceinline__ const char* abase(const Unit& u) const { return (const char*)A + (size_t)u.pm * TSTEP_D; }
    __device__ __forceinline__ const char* bbase(const Unit& u) const { return (const char*)Bt + (size_t)u.pn * TSTEP_D; }
    __device__ __forceinline__ void goffs(const Unit&, const int (&)[2], const int (&)[2], unsigned (&)[2][2]) const {}
    struct Regs { f32x4 xa, xb; };
    __device__ __forceinline__ void pre(const Unit&, int ru, int cu, int fr, int fq, Regs& R) const {
        const unsigned v = (unsigned)(fr * (D * 4) + fq * 16), so = (unsigned)ru * (unsigned)(D * 4) + (unsigned)cu * 4u;
        R.xa = bld4f(xin, v, so); R.xb = bld4f(xin, v + 64u, so);
    }
    __device__ __forceinline__ void post(const Unit&, int ru, int cu, int fr, int fq, const Regs& R, f32x4 va, f32x4 vb) const {
        const unsigned v = (unsigned)(fr * (D * 4) + fq * 16), so = (unsigned)ru * (unsigned)(D * 4) + (unsigned)cu * 4u;
        bst4f(xout, v, so, R.xa + va); bst4f(xout, v + 64u, so, R.xb + vb);
    }
    __device__ __forceinline__ void epi(f32x4 (&acc)[2][2][4][2], const Unit& u, int wr, int wc, int fr, int fq) const { pg8::run_epi<2>(*this, acc, u, wr, wc, fr, fq); }
};
constexpr int MOE_TAB_MAX = 192;
__device__ __forceinline__ void moe_build_table(const unsigned* cnt, LAS int* cntL, LAS int* tab, LAS int* ntl, int tid) {
    if (tid < NE) cntL[tid] = (int)ld_agent(cnt + tid);
    __syncthreads();
    if (tid == 0) { int acc = 0; for (int e = 0; e < NE; ++e) { const int nt = (cntL[e] + 255) >> 8; for (int it = 0; it < nt; ++it) tab[acc + it] = (e << 8) | it; acc += nt; } ntl[0] = acc; }
    __syncthreads();
}
__device__ __forceinline__ bool moe_next(int i, int G, int c, int ntiles, const LAS int* tab, const LAS int* cntL, Unit& u) {
    const int L = i * G + c; if (L >= 4 * ntiles) return false;
    const int ti = L >> 2, ent = __builtin_amdgcn_readfirstlane(tab[ti]);
    u.pm = ti; u.pn = L & 3; u.e = ent >> 8; u.it = ent & 255; u.ne = __builtin_amdgcn_readfirstlane(cntL[ent >> 8]); return true;
}
struct ProbMoe1 {
    static constexpr bool GATHER = true, CHAIN = false; __device__ __forceinline__ bool chain(const Unit&) const { return false; }
    const bf16_t* H2; const bf16_t* W13; int K; int G, c;
    const LAS int* cntL; const LAS int* tab; int ntiles;
    rsrc_t wsr;
    __device__ __forceinline__ bool next(int i, Unit& u) const { return moe_next(i, G, c, ntiles, tab, cntL, u); }
    __device__ __forceinline__ const char* abase(const Unit&) const { return (const char*)H2; }
    __device__ __forceinline__ const char* bbase(const Unit& u) const { return (const char*)W13 + ((size_t)u.e * 1024 + (size_t)u.pn * 256) * D * 2; }
    __device__ __forceinline__ void goffs(const Unit& u, const int (&R)[2], const int (&C)[2], unsigned (&o)[2][2]) const {
#pragma unroll
        for (int h = 0; h < 2; ++h)
#pragma unroll
            for (int i = 0; i < 2; ++i) {
                const int idx = u.it * 256 + h * 128 + R[i];
                const int tok = (int)__builtin_amdgcn_raw_buffer_load_b32(wsr, (unsigned)(R[i] * 4), (unsigned)WS_STOK + (unsigned)(u.e * CAP + u.it * 256 + h * 128) * 4u, 0);
                o[h][i] = (unsigned)((idx < u.ne ? tok : T) * D + C[i]) * 2u;
            }
    }
    struct Regs {};
    __device__ __forceinline__ void pre(const Unit&, int, int, int, int, Regs&) const {}
    __device__ __forceinline__ void post(const Unit&, int ru, int cu, int fr, int fq, const Regs&, f32x4 va, f32x4 vb) const {
        bst4bf(wsr, (unsigned)(fr * (DFF * 2) + fq * 8), (unsigned)WS_ACT + (unsigned)ru * (unsigned)(DFF * 2) + (unsigned)pcu(cu) * 2u, silu4(va) * vb);
    }
    __device__ __forceinline__ void epi(f32x4 (&acc)[2][2][4][2], const Unit& u, int wr, int wc, int fr, int fq) const { pg8::run_epi<1>(*this, acc, u, wr, wc, fr, fq); }
};
struct ProbMoe2 {
    static constexpr bool GATHER = false, CHAIN = false; __device__ __forceinline__ bool chain(const Unit&) const { return false; }
    const bf16_t* ACT; const bf16_t* W2; int K; int G, c;
    const LAS int* cntL; const LAS int* tab; int ntiles;
    rsrc_t wsr;
    __device__ __forceinline__ bool next(int i, Unit& u) const { return moe_next(i, G, c, ntiles, tab, cntL, u); }
    __device__ __forceinline__ const char* abase(const Unit& u) const { return (const char*)ACT + (size_t)u.pm * 256 * DFF * 2; }
    __device__ __forceinline__ const char* bbase(const Unit& u) const { return (const char*)W2 + ((size_t)u.e * 1024 + (size_t)u.pn * 256) * DFF * 2; }
    __device__ __forceinline__ void goffs(const Unit&, const int (&)[2], const int (&)[2], unsigned (&)[2][2]) const {}
    struct Regs { unsigned w, asg; };
    __device__ __forceinline__ void pre(const Unit& u, int ru, int, int fr, int, Regs& R) const {
        const unsigned ss = (unsigned)(u.e * CAP + u.it * 256 + (ru - u.pm * 256)) * 4u;
        R.w = __builtin_amdgcn_raw_buffer_load_b32(wsr, (unsigned)(fr * 4), (unsigned)WS_SW + ss, 0); R.asg = __builtin_amdgcn_raw_buffer_load_b32(wsr, (unsigned)(fr * 4), (unsigned)WS_SASG + ss, 0);
    }
    __device__ __forceinline__ void post(const Unit& u, int ru, int cu, int fr, int fq, const Regs& R, f32x4 va, f32x4 vb) const {
        const int idx = u.it * 256 + (ru - u.pm * 256) + fr;
        const float w = __uint_as_float(R.w);
        const unsigned v = idx < u.ne ? R.asg * (unsigned)(D * 2) + (unsigned)(fq * 8) : 0xC0000000u;
        const unsigned so = (unsigned)WS_YC + (unsigned)cu * 2u;
        bst4bf(wsr, v, so, va * w); bst4bf(wsr, v + 32u, so, vb * w);
    }
    __device__ __forceinline__ void epi(f32x4 (&acc)[2][2][4][2], const Unit& u, int wr, int wc, int fr, int fq) const { pg8::run_epi<4>(*this, acc, u, wr, wc, fr, fq); }
};

#define XB_TMO      128
#define XB_XCNT(j)  (256  + 64 * (j))
#define XB_XSUB(j)  (1280 + 64 * (j))
#define XB_XGEN(j)  (2304 + 64 * (j))
#define XB_TOP      3328
#define XB_TOPGEN   3392
#define XCD_BAR_WORDS 3456
#define XB_SPIN_CAP (1u << 18)
__device__ __forceinline__ unsigned xb_ld(unsigned* p)              { return __hip_atomic_load(p, __ATOMIC_RELAXED, __HIP_MEMORY_SCOPE_AGENT); }
__device__ __forceinline__ unsigned xb_add(unsigned* p, unsigned v) { return __hip_atomic_fetch_add(p, v, __ATOMIC_RELAXED, __HIP_MEMORY_SCOPE_AGENT); }
__device__ __forceinline__ unsigned xb_xcc_id() { return (unsigned)__builtin_amdgcn_s_getreg((3 << 11) | 20) & 0xFu; }
#define XB_SPIN(cond, bar) do { unsigned _sp = 0; while (cond) { __builtin_amdgcn_s_sleep(1); \
    if ((++_sp & 255u) == 0u) { if (xb_ld(&(bar)[XB_TMO])) break; if (_sp > XB_SPIN_CAP) { atomicAdd(&(bar)[XB_TMO], 1u); break; } } } } while (0)
struct XcdBarrier {
    unsigned* bar; unsigned x;
    volatile LAS unsigned* st;
};
__device__ __forceinline__ XcdBarrier xcd_barrier_post(unsigned* bar, volatile LAS unsigned* st) {
    XcdBarrier b; b.bar = bar; b.x = xb_xcc_id(); b.st = st;
    if (threadIdx.x == 0) (void)xb_add(&bar[XB_XCNT(b.x)], 1u);
    return b;
}
__device__ __forceinline__ void xcd_barrier_complete(unsigned* bar, unsigned x, unsigned& nloc, unsigned& nx) {
    const unsigned G = gridDim.x * gridDim.y * gridDim.z;
    unsigned sum, cnt, mine, sp = 0u;
    for (;;) {
        sum = 0u; cnt = 0u; mine = 0u;
#pragma unroll
        for (unsigned j = 0; j < 16; ++j) { const unsigned c = xb_ld(&bar[XB_XCNT(j)]); sum += c; cnt += (c > 0u) ? 1u : 0u; mine = (j == x) ? c : mine; }
        if (sum == G) break;
        __builtin_amdgcn_s_sleep(1);
        if ((++sp & 255u) == 0u) { if (xb_ld(&bar[XB_TMO])) break; if (sp > XB_SPIN_CAP) { atomicAdd(&bar[XB_TMO], 1u); break; } }
    }
    nloc = mine > 0u ? mine : 1u; nx = cnt > 0u ? cnt : 1u;
}
__device__ __forceinline__ void xcd_barrier(const XcdBarrier& b) {
    asm volatile("s_waitcnt vmcnt(0)" ::: "memory");
    __syncthreads();
    if (threadIdx.x == 0) {
        unsigned* bar = b.bar;
        __builtin_amdgcn_s_waitcnt(0);
        unsigned nloc = b.st[0], nx = b.st[1];
        if (nloc == 0u) { xcd_barrier_complete(bar, b.x, nloc, nx); b.st[0] = nloc; b.st[1] = nx; }
        const unsigned old = xb_add(&bar[XB_XSUB(b.x)], 1u);
        const unsigned gen = old / nloc;
        if (old + 1u == (gen + 1u) * nloc) {
            __builtin_amdgcn_fence(__ATOMIC_RELEASE, "agent");
            asm volatile("s_waitcnt vmcnt(0)" ::: "memory");
            const unsigned og = xb_add(&bar[XB_TOP], 1u);
            const unsigned tg = og / nx;
            if (og + 1u == (tg + 1u) * nx) xb_add(&bar[XB_TOPGEN], 1u);
            else XB_SPIN(xb_ld(&bar[XB_TOPGEN]) == tg, bar);
            __builtin_amdgcn_fence(__ATOMIC_ACQUIRE, "agent");
            xb_add(&bar[XB_XGEN(b.x)], 1u);
            asm volatile("s_waitcnt vmcnt(0)" ::: "memory");
        } else {
            XB_SPIN(xb_ld(&bar[XB_XGEN(b.x)]) == gen, bar);
            __builtin_amdgcn_fence(__ATOMIC_ACQUIRE, "agent");
            asm volatile("s_waitcnt vmcnt(0)" ::: "memory");
        }
    }
    __syncthreads();
}

static_assert(MOE_OFF + (32 + MOE_TAB_MAX + 4) * 4 <= RT_LOG && MID_LDS <= RING_BYTES && 256 * 65 * 4 <= RING_BYTES, "LDS map");
static_assert(WS_U - WS_CB == WS_CB - WS_BA && WS_WC - WS_WB == WS_WB - WS_WA, "branch operands equally spaced");
constexpr int NPH = 8 * NL + 1;

struct Args { const float* in[24]; float* out; unsigned char* ws; int ph_lo, ph_hi, bar_region, pad; CvtTable tb[NL]; };
#define WSA(type, off) ((type*)(a->ws + (off)))
#define KARGS() ({ const CAS Args* q_ = kp; asm volatile("" : "+s"(q_)); q_; })

#ifndef PROBE_MASK
#define PROBE_MASK 0
#endif
__global__ void __launch_bounds__(512, 2) mk_fwd(Args a_unused) {
    extern __shared__ __attribute__((aligned(16))) unsigned char lds_[];
    LAS unsigned char* lds = (LAS unsigned char*)lds_;
    volatile LAS unsigned* MISC = (volatile LAS unsigned*)(lds + MISC_OFF);
    for (int u = threadIdx.x; u < (LDS_BYTES - LDSCTL_OFF) / 4; u += 512) ((LAS unsigned*)(lds + LDSCTL_OFF))[u] = 0u;
    __syncthreads();
    const CAS Args* kp = (const CAS Args*)__builtin_amdgcn_kernarg_segment_ptr();
    int lo, hi; XcdBarrier bar;
    { const CAS Args* a = KARGS(); lo = a->ph_lo; hi = a->ph_hi; bar = xcd_barrier_post(WSA(unsigned, WS_CTL) + CW_BAR + a->bar_region * XCD_BAR_WORDS, MISC + 8); }
#ifndef PHMASK
#define PHMASK 0x1ff
#endif
#define IN(k) (((PHMASK >> (((k) == 8 * NL) ? 8 : ((k) & 7))) & 1) && lo <= (k) && (k) < hi)
#define PHASE_REGS() int tid = threadIdx.x; asm volatile("" : "+v"(tid)); int bid = blockIdx.x, G = gridDim.x; asm volatile("" : "+s"(bid), "+s"(G))
#define SEAM(k) do { if ((k) + 1 < hi) xcd_barrier(bar); } while (0)
    LAS int* cntL = (LAS int*)(lds + MOE_OFF); LAS int* tabL = cntL + 32; LAS int* ntl = tabL + MOE_TAB_MAX;
    unsigned long long probe_t = 0ull, probe_t0 = 0ull; (void)probe_t0;
#define PB(j) do { if ((PROBE_MASK >> (j)) & 1) probe_t0 = __builtin_amdgcn_s_memrealtime(); } while (0)
#define PE(j) do { if ((PROBE_MASK >> (j)) & 1) probe_t += __builtin_amdgcn_s_memrealtime() - probe_t0; } while (0)

    for (int l = 0; l < NL; ++l) {
        const int k0 = 8 * l;
        if (IN(k0 + 0)) { PB(0);
            PHASE_REGS(); const CAS Args* a = KARGS(); bf16_t* const Hb = WSA(bf16_t, WS_H); unsigned* const ctl = WSA(unsigned, WS_CTL); (void)ctl; (void)Hb;
            if (l == 0) cvt_phase(&a->tb[0], 0, NCVT, G, 0, (LAS float*)lds, tid, bid, G);
            if (l == 0 && bid < 4) { unsigned* z = WSA(unsigned, WS_ZB) + (size_t)((bid >> 1) * ZSEQ + (bid & 1) * (SEQ + ZPAD)) * (D / 2); for (int i = tid; i < ZPAD * D / 2; i += 512) z[i] = 0u; }
            { const int row = bid * 8 + (tid >> 6); if (row < NHC * 128) { const float* wp = a->in[11] + ((size_t)l * NHC * 128 + row) * 128 + (tid & 63); const float sm = wave_sum(wp[0] + wp[64]); if ((tid & 63) == 0) WSA(float, WS_STAT)[row] = sm; } }
            if (l == 0) norm_phase<false, false>(a->in[0], nullptr, nullptr, a->in[1], Hb, nullptr, tid, bid, G);
            else norm_phase<true, false>(a->out, a->out, WSA(bf16_t, WS_YC), a->in[1] + l * D, Hb, nullptr, tid, bid, G);
            SEAM(k0 + 0); PE(0);
        }
        if (IN(k0 + 1)) { PB(1);
            PHASE_REGS(); const CAS Args* a = KARGS(); bf16_t* const Hb = WSA(bf16_t, WS_H); unsigned* const ctl = WSA(unsigned, WS_CTL); (void)ctl; (void)Hb;
            ProbInProj P; P.A = Hb; P.Bt = WSA(bf16_t, WS_WIN); P.K = D; P.S.init(T, DIN, G, bid);
            P.wsr = mkrsrc(a->ws, (unsigned)WS_END);
            pg8::gemm_phase<ProbInProj, true>(lds, P, tid);
            SEAM(k0 + 1); PE(1);
        }
        if (IN(k0 + 2)) { PB(2);
            PHASE_REGS(); const CAS Args* a = KARGS(); bf16_t* const Hb = WSA(bf16_t, WS_H); unsigned* const ctl = WSA(unsigned, WS_CTL); (void)ctl; (void)Hb;
            mid_phase(mkrsrc(a->ws, (unsigned)WS_END), a->ws, WSA(bf16_t, WS_V),
                      a->in[3] + (size_t)l * 3 * D, a->in[5] + (size_t)l * 31 * D, a->in[6] + l * D, a->in[7] + l * D, a->in[9] + l * D, a->in[10] + l * D,
                      a->in[11] + (size_t)l * NHC * 128 * 128, a->in[12] + l * NHC * 128, WSA(float, WS_STAT), lds, tid, bid, G, probe_t);
            SEAM(k0 + 2); PE(2);
        }
        if (IN(k0 + 3)) { PB(3);
            PHASE_REGS(); const CAS Args* a = KARGS(); bf16_t* const Hb = WSA(bf16_t, WS_H); unsigned* const ctl = WSA(unsigned, WS_CTL); (void)ctl; (void)Hb;
            ProbBranch P; P.ws = a->ws;
            P.K = D; P.S.init(T, D, G, bid); P.wsr = mkrsrc(a->ws, (unsigned)WS_END);
            pg8::gemm_phase<ProbBranch, true>(lds, P, tid);
            SEAM(k0 + 3); PE(3);
        }
        if (IN(k0 + 4)) { PB(4);
            PHASE_REGS(); const CAS Args* a = KARGS(); bf16_t* const Hb = WSA(bf16_t, WS_H); unsigned* const ctl = WSA(unsigned, WS_CTL); (void)ctl; (void)Hb;
            ProbWo P; P.A = Hb; P.Bt = WSA(bf16_t, WS_WO); P.K = D; P.S.init(T, D, G, bid); P.xin = mkrsrc((l == 0) ? a->in[0] : a->out, (unsigned)((size_t)T * D * 4)); P.xout = mkrsrc(a->out, (unsigned)((size_t)T * D * 4));
            pg8::gemm_phase<ProbWo, false>(lds, P, tid);
            SEAM(k0 + 4); PE(4);
        }
        if (IN(k0 + 5)) { PB(5);
            PHASE_REGS(); const CAS Args* a = KARGS(); bf16_t* const Hb = WSA(bf16_t, WS_H); unsigned* const ctl = WSA(unsigned, WS_CTL); (void)ctl; (void)Hb;
            router_phase(a->out, a->in[15] + l * D, a->in[16] + (size_t)l * D * NG, a->in[17] + l * NG, a->in[18] + (size_t)l * D * NE, a->in[19] + l * NE,
                         Hb, ctl + CW_CNT + 64 * l, WSA(int, WS_STOK), WSA(float, WS_SW), WSA(int, WS_SASG), lds, tid, bid, G);
            SEAM(k0 + 5); PE(5);
        }
        if (IN(k0 + 6)) { PB(6);
            PHASE_REGS(); const CAS Args* a = KARGS(); bf16_t* const Hb = WSA(bf16_t, WS_H); unsigned* const ctl = WSA(unsigned, WS_CTL); (void)ctl; (void)Hb;
            moe_build_table(ctl + CW_CNT + 64 * l, cntL, tabL, ntl, tid);
            ProbMoe1 P; P.H2 = Hb; P.W13 = WSA(bf16_t, WS_W13); P.K = D; P.G = G; P.c = bid; P.cntL = cntL; P.tab = tabL; P.ntiles = __builtin_amdgcn_readfirstlane(ntl[0]); P.wsr = mkrsrc(a->ws, (unsigned)WS_END);
            pg8::gemm_phase<ProbMoe1, true>(lds, P, tid);
            if (l + 1 < NL) { const int rem = (4 * P.ntiles) % G; cvt_phase(&a->tb[l + 1], 0, NCVT - 1, rem == 0 ? G : rem, 8, (LAS float*)lds, tid, bid, G); }
            SEAM(k0 + 6); PE(6);
        }
        if (IN(k0 + 7)) { PB(7);
            PHASE_REGS(); const CAS Args* a = KARGS(); bf16_t* const Hb = WSA(bf16_t, WS_H); unsigned* const ctl = WSA(unsigned, WS_CTL); (void)ctl; (void)Hb;
            moe_build_table(ctl + CW_CNT + 64 * l, cntL, tabL, ntl, tid);
            ProbMoe2 P; P.ACT = WSA(bf16_t, WS_ACT); P.W2 = (l & 1) ? WSA(bf16_t, WS_W2B) : WSA(bf16_t, WS_W2); P.K = DFF; P.G = G; P.c = bid; P.cntL = cntL; P.tab = tabL; P.ntiles = __builtin_amdgcn_readfirstlane(ntl[0]); P.wsr = mkrsrc(a->ws, (unsigned)WS_END);
            pg8::gemm_phase<ProbMoe2, true>(lds, P, tid);
            if (l + 1 < NL) { const int rem = (4 * P.ntiles) % G; cvt_phase(&a->tb[l + 1], NCVT - 1, NCVT, rem == 0 ? G : rem, 4, (LAS float*)lds, tid, bid, G); }
            SEAM(k0 + 7); PE(7);
        }
    }
    if (IN(8 * NL)) { PHASE_REGS(); const CAS Args* a = KARGS(); norm_phase<true, true>(a->out, nullptr, WSA(bf16_t, WS_YC), a->in[23], nullptr, a->out, tid, bid, G); }
    if ((PROBE_MASK != 0 || PROBE_MID != 0) && blockIdx.x == 0) { const unsigned long long t = __builtin_amdgcn_s_memrealtime(); while (__builtin_amdgcn_s_memrealtime() - t < probe_t) __builtin_amdgcn_s_sleep(8); }
#undef IN
#undef SEAM
}

static void build_cvt(CvtTable& tb, void* const* d_in, unsigned char* ws, int l) {
    const float* w_in = (const float*)d_in[2] + (size_t)l * D * DIN;
    auto set = [&](int i, const float* A, const float* B, bf16_t* dst, int ld, int K, int ndst, int pair, int cA, int cB, int batch, long sb, long db) {
        CvtDesc& c = tb.d[i]; c.A = A; c.B = B; c.dst = dst; c.ld = ld; c.K = K; c.ndst = ndst; c.pair = pair; c.colA0 = cA; c.colB0 = cB; c.batch = batch; c.sbatch = sb; c.dbatch = db;
        c.items = batch * (ndst / 64) * (K / 256); };
    bf16_t* win = (bf16_t*)(ws + WS_WIN);
    set(0, w_in, w_in, win, DIN, D, 2048, 1, 0, 2048, 1, 0, 0);
    set(1, w_in, nullptr, win + (size_t)2048 * D, DIN, D, 1024, 0, 1024, 0, 1, 0, 0);
    set(2, w_in, w_in, win + (size_t)3072 * D, DIN, D, 2048, 1, 3072, 4096, 1, 0, 0);
    set(3, w_in, nullptr, win + (size_t)5120 * D, DIN, D, 2048, 0, 5120, 0, 1, 0, 0);
    set(4, w_in, nullptr, win + (size_t)7168 * D, DIN, D, 3072, 0, 7168, 0, 1, 0, 0);
    set(5, (const float*)d_in[4] + (size_t)l * D * D, nullptr, (bf16_t*)(ws + WS_WA), D, D, D, 0, 0, 0, 1, 0, 0);
    set(6, (const float*)d_in[8] + (size_t)l * D * D, nullptr, (bf16_t*)(ws + WS_WB), D, D, D, 0, 0, 0, 1, 0, 0);
    set(7, (const float*)d_in[13] + (size_t)l * D * D, nullptr, (bf16_t*)(ws + WS_WC), D, D, D, 0, 0, 0, 1, 0, 0);
    set(8, (const float*)d_in[14] + (size_t)l * D * D, nullptr, (bf16_t*)(ws + WS_WO), D, D, D, 0, 0, 0, 1, 0, 0);
    set(9, (const float*)d_in[22] + (size_t)l * NE * DFF * D, nullptr, (bf16_t*)(ws + ((l & 1) ? WS_W2B : WS_W2)), D, DFF, D, 0, 0, 0, NE, (long)DFF * D, (long)D * DFF);
    set(10, (const float*)d_in[20] + (size_t)l * NE * D * DFF, (const float*)d_in[21] + (size_t)l * NE * D * DFF, (bf16_t*)(ws + WS_W13), DFF, D, 1024, 1, 0, 0, NE, (long)D * DFF, (long)1024 * D);
    tb.total = 0; for (int i = 0; i < NCVT; ++i) tb.total += tb.d[i].items; tb.pad = 0;
}

#ifndef MK_CUTS
#define MK_CUTS 0
#endif

extern "C" void kernel_launch(void* const* d_in, const int* in_sizes, int n_in, void* d_out, int out_size, void* d_ws, size_t ws_size, hipStream_t stream) {
    static int grid = 0;
    if (grid == 0) {
        if (n_in != 24 || ws_size < WS_END) { fprintf(stderr, "kernel_launch: unexpected n_in %d or ws_size %zu < %zu\n", n_in, ws_size, (size_t)WS_END); grid = -1; return; }
        int dev = 0, cus = 0, per_cu = 0;
        if (hipGetDevice(&dev) != hipSuccess || hipDeviceGetAttribute(&cus, hipDeviceAttributeMultiprocessorCount, dev) != hipSuccess) { grid = -1; return; }
        if (hipFuncSetAttribute((const void*)mk_fwd, hipFuncAttributeMaxDynamicSharedMemorySize, LDS_BYTES) != hipSuccess) { fprintf(stderr, "kernel_launch: hipFuncSetAttribute failed\n"); grid = -1; return; }
        if (hipOccupancyMaxActiveBlocksPerMultiprocessor(&per_cu, (const void*)mk_fwd, 512, LDS_BYTES) != hipSuccess || per_cu < 1) { fprintf(stderr, "kernel_launch: occupancy query says %d\n", per_cu); }
        (void)hipGetLastError();
        grid = cus;
    }
    if (grid < 0) return;
    unsigned char* ws = (unsigned char*)d_ws;
    (void)hipMemsetAsync(ws + WS_CTL, 0, CTL_BYTES, stream);
    Args a{};
    for (int i = 0; i < 24; ++i) a.in[i] = (const float*)d_in[i];
    a.out = (float*)d_out; a.ws = ws;
    for (int l = 0; l < NL; ++l) build_cvt(a.tb[l], d_in, ws, l);
#if MK_CUTS == 0
    a.ph_lo = 0; a.ph_hi = NPH; a.bar_region = 0;
    hipLaunchKernelGGL(mk_fwd, dim3(grid), dim3(512), LDS_BYTES, stream, a);
#elif MK_CUTS == 1
    for (int k = 0; k < NPH; ++k) { a.ph_lo = k; a.ph_hi = k + 1; a.bar_region = 0; hipLaunchKernelGGL(mk_fwd, dim3(grid), dim3(512), LDS_BYTES, stream, a); }
#else
    a.ph_lo = 0; a.ph_hi = 8; a.bar_region = 0; hipLaunchKernelGGL(mk_fwd, dim3(grid), dim3(512), LDS_BYTES, stream, a);
    a.ph_lo = 8; a.ph_hi = NPH; a.bar_region = 1; hipLaunchKernelGGL(mk_fwd, dim3(grid), dim3(512), LDS_BYTES, stream, a);
#endif
}
```

```cpp
#include <hip/hip_runtime.h>
#include <stdint.h>
#include <stdio.h>

#define LAS __attribute__((address_space(3)))
#define CAS __attribute__((address_space(4)))
typedef unsigned short bf16_t;
typedef short bf16x8 __attribute__((ext_vector_type(8)));
typedef float f32x4 __attribute__((ext_vector_type(4)));
typedef float f32x2 __attribute__((ext_vector_type(2)));
typedef unsigned u32x4 __attribute__((ext_vector_type(4)));
typedef unsigned u32x2 __attribute__((ext_vector_type(2)));

constexpr int T = 16384, D = 1024, SEQ = 8192, DIN = 10240, NE = 32, NG = 4, EPG = 8, DFF = 512, NHC = 8;
constexpr int CAP = 16384;
constexpr int NL = 2;
constexpr float RMS_EPS = 1e-6f, LN_EPS = 1e-5f;

constexpr size_t MiB = 1u << 20;
constexpr size_t WS_CTL = 0, CTL_BYTES = 32768;
constexpr size_t WS_WIN = 2 * MiB, WS_WA = 22 * MiB, WS_WB = 24 * MiB, WS_WC = 26 * MiB, WS_WO = 28 * MiB, WS_W13 = 30 * MiB, WS_W2 = 94 * MiB;
constexpr size_t WS_H = 126 * MiB;
constexpr size_t WS_QA = 159 * MiB, WS_BA = 191 * MiB, WS_U = 255 * MiB, WS_V = 287 * MiB, WS_G = 319 * MiB;
constexpr size_t WS_W2B = 415 * MiB;
constexpr size_t WS_ZB = 447 * MiB;
constexpr int ZPAD = 15, ZSEQ = SEQ + 2 * ZPAD;
constexpr size_t WS_CB = 223 * MiB;
constexpr size_t WS_ACT = WS_QA;
constexpr size_t WS_YC = 223 * MiB;
constexpr size_t WS_STOK = 511 * MiB, WS_SW = 513 * MiB, WS_SASG = 515 * MiB;
constexpr size_t WS_STAT = 517 * MiB;
constexpr size_t WS_PART = 485 * MiB;
constexpr size_t WS_SRS = 481 * MiB;
constexpr size_t WS_END = 518 * MiB;
constexpr int CW_CNT = 0;
constexpr int CW_BAR = 1024;

__device__ __forceinline__ unsigned cvt_pk_bf16(float lo, float hi) { unsigned r; asm volatile("v_cvt_pk_bf16_f32 %0, %1, %2" : "=v"(r) : "v"(lo), "v"(hi)); return r; }
__device__ __forceinline__ float bf_lo(unsigned p) { return __uint_as_float(p << 16); }
__device__ __forceinline__ float bf_hi(unsigned p) { return __uint_as_float(p & 0xffff0000u); }
__device__ __forceinline__ float wave_sum(float v) {
#pragma unroll
    for (int o = 1; o < 64; o <<= 1) v += __shfl_xor(v, o);
    return v;
}
__device__ __forceinline__ float sigmoidf_(float x) { return __builtin_amdgcn_rcpf(1.0f + __expf(-x)); }
__device__ __forceinline__ float siluf_(float x) { return x * sigmoidf_(x); }
__device__ __forceinline__ float gelu_tanh_(float x) { const float z = 0.7978845608028654f * (x + 0.044715f * x * x * x); return x * sigmoidf_(2.0f * z); }
__device__ __forceinline__ f32x4 sig4(f32x4 v) { return (f32x4){sigmoidf_(v[0]), sigmoidf_(v[1]), sigmoidf_(v[2]), sigmoidf_(v[3])}; }
__device__ __forceinline__ f32x4 silu4(f32x4 v) { return (f32x4){siluf_(v[0]), siluf_(v[1]), siluf_(v[2]), siluf_(v[3])}; }
__device__ __forceinline__ f32x4 gelu4(f32x4 v) { return (f32x4){gelu_tanh_(v[0]), gelu_tanh_(v[1]), gelu_tanh_(v[2]), gelu_tanh_(v[3])}; }
__device__ __forceinline__ void store4bf(bf16_t* p, f32x4 v) { u32x2 w; w.x = cvt_pk_bf16(v[0], v[1]); w.y = cvt_pk_bf16(v[2], v[3]); *(u32x2*)p = w; }
__device__ __forceinline__ f32x4 load4bf(const bf16_t* p) { const u32x2 w = *(const u32x2*)p; return (f32x4){bf_lo(w.x), bf_hi(w.x), bf_lo(w.y), bf_hi(w.y)}; }
__device__ __forceinline__ unsigned ld_agent(const unsigned* p) { return __hip_atomic_load(p, __ATOMIC_RELAXED, __HIP_MEMORY_SCOPE_AGENT); }

typedef __amdgpu_buffer_rsrc_t rsrc_t;
__device__ __forceinline__ rsrc_t mkrsrc(const void* p, unsigned bytes) { return __builtin_amdgcn_make_buffer_rsrc(const_cast<void*>(p), (short)0, (int)bytes, 0x00020000); }
__device__ __forceinline__ f32x4 bld4bf(rsrc_t r, unsigned voff, unsigned soff) { const u32x2 w = __builtin_amdgcn_raw_buffer_load_b64(r, voff, soff, 0); return (f32x4){bf_lo(w.x), bf_hi(w.x), bf_lo(w.y), bf_hi(w.y)}; }
__device__ __forceinline__ void bst4bf(rsrc_t r, unsigned voff, unsigned soff, f32x4 v) { u32x2 w; w.x = cvt_pk_bf16(v[0], v[1]); w.y = cvt_pk_bf16(v[2], v[3]); __builtin_amdgcn_raw_buffer_store_b64(w, r, voff, soff, 0); }
__device__ __forceinline__ f32x4 bld4f(rsrc_t r, unsigned voff, unsigned soff) { const u32x4 w = __builtin_amdgcn_raw_buffer_load_b128(r, voff, soff, 0); return (f32x4){__uint_as_float(w.x), __uint_as_float(w.y), __uint_as_float(w.z), __uint_as_float(w.w)}; }
__device__ __forceinline__ void bst4f(rsrc_t r, unsigned voff, unsigned soff, f32x4 v) { u32x4 w; w.x = __float_as_uint(v[0]); w.y = __float_as_uint(v[1]); w.z = __float_as_uint(v[2]); w.w = __float_as_uint(v[3]); __builtin_amdgcn_raw_buffer_store_b128(w, r, voff, soff, 0); }
__device__ __forceinline__ int pair_col(int c) { return 32 * (c >> 6) + 16 * ((c >> 5) & 1) + (c & 15); }

struct CvtDesc { const float* A; const float* B; bf16_t* dst; long sbatch, dbatch; int ld, K, ndst, pair, colA0, colB0, batch, items; };
constexpr int NCVT = 11;
struct CvtTable { CvtDesc d[NCVT]; int total, pad; };

struct CvtItem { const float* A; const float* B; bf16_t* dst; int ld, K, pair, cA, cB, nb, k0; };
__device__ __forceinline__ void cvt_decode(const CAS CvtTable* tb, int dlo, int dhi, int it, CvtItem& x) {
    int r = it, di = dlo;
    while (di < dhi - 1 && r >= tb->d[di].items) { r -= tb->d[di].items; ++di; }
    const int K = tb->d[di].K, ntn = tb->d[di].ndst / 64, ntk = K / 256;
    const int b = r / (ntn * ntk), rem = r % (ntn * ntk);
    x.nb = rem / ntk; x.k0 = (rem % ntk) * 256; x.K = K; x.ld = tb->d[di].ld; x.pair = tb->d[di].pair; x.cA = tb->d[di].colA0; x.cB = tb->d[di].colB0;
    x.A = tb->d[di].A + (size_t)b * tb->d[di].sbatch; x.B = tb->d[di].B ? tb->d[di].B + (size_t)b * tb->d[di].sbatch : x.A; x.dst = tb->d[di].dst + (size_t)b * tb->d[di].dbatch;
}
__device__ __forceinline__ void cvt_load(const CvtItem& x, int tid, f32x4 (&R)[8]) {
#pragma unroll
    for (int i = 0; i < 8; ++i) {
        const int idx = tid + 512 * i, kk = idx >> 4, s16 = idx & 15;
        const float* src = (x.pair && (s16 >> 3)) ? x.B : x.A;
        const int col = x.pair ? ((s16 >> 3) ? x.cB : x.cA) + 32 * x.nb + 4 * (s16 & 7) : x.cA + 64 * x.nb + 4 * s16;
        R[i] = *(const f32x4*)(src + (size_t)(x.k0 + kk) * x.ld + col);
    }
}
__device__ __forceinline__ void cvt_phase(const CAS CvtTable* tb, int dlo, int dhi, int r, int credit, LAS float* tile, int tid, int bid, int nblk) {
    int total = 0; for (int d = dlo; d < dhi; ++d) total += tb->d[d].items;
    const int lane = tid & 63, wid = tid >> 6;
    int F = (nblk - r) * credit; F = F < total ? F : total;
    int nfront = 0; if (bid >= r) { nfront = F - (bid - r) * credit; nfront = nfront < 0 ? 0 : (nfront > credit ? credit : nfront); }
#define CVT_ITEM(j) ((j) < nfront ? (bid - r) * credit + (j) : F + ((j) - nfront) * nblk + bid)
    int j = 0, it = CVT_ITEM(0); if (it >= total) return;
    CvtItem cur, nxt; f32x4 R[8];
    cvt_decode(tb, dlo, dhi, it, cur); cvt_load(cur, tid, R);
    for (;;) {
#pragma unroll
        for (int i = 0; i < 8; ++i) {
            const int idx = tid + 512 * i, kk = idx >> 4, s16 = idx & 15;
#pragma unroll
            for (int e = 0; e < 4; ++e) {
                const int c32 = 4 * (s16 & 7) + e;
                const int nl = cur.pair ? (((c32 >> 4) * 2 + (s16 >> 3)) * 16 + (c32 & 15)) : 4 * s16 + e;
                tile[kk * 65 + nl] = R[i][e];
            }
        }
        __syncthreads();
        const int itn = CVT_ITEM(j + 1); const bool more = itn < total;
        if (more) { cvt_decode(tb, dlo, dhi, itn, nxt); cvt_load(nxt, tid, R); }
#pragma unroll
        for (int i = 0; i < 4; ++i) {
            const int task = wid * 4 + i, nl = (task & 7) * 8 + (lane >> 3), ch = (task >> 3) * 8 + (lane & 7);
            const LAS float* sp = tile + (8 * ch) * 65 + nl;
            u32x4 o; o.x = cvt_pk_bf16(sp[0], sp[65]); o.y = cvt_pk_bf16(sp[2 * 65], sp[3 * 65]); o.z = cvt_pk_bf16(sp[4 * 65], sp[5 * 65]); o.w = cvt_pk_bf16(sp[6 * 65], sp[7 * 65]);
            *(u32x4*)(cur.dst + (size_t)(cur.nb * 64 + nl) * cur.K + cur.k0 + 8 * ch) = o;
        }
        __syncthreads();
        if (!more) break;
        ++j; it = itn; cur = nxt;
    }
#undef CVT_ITEM
}

template <bool COMBINE, bool FINAL>
__device__ __forceinline__ void norm_phase(const float* xsrc, float* xbuf, const bf16_t* yc, const float* g, bf16_t* h, float* outf, int tid, int bid, int nblk) {
    const int lane = tid & 63, wave = tid >> 6, nw = 8;
    f32x4 gv[4];
#pragma unroll
    for (int j = 0; j < 4; ++j) gv[j] = *(const f32x4*)(g + 4 * lane + 256 * j);
    for (int row = bid * nw + wave; row < T; row += nblk * nw) {
        f32x4 v[4]; float ss = 0.f;
#pragma unroll
        for (int j = 0; j < 4; ++j) {
            v[j] = *(const f32x4*)(xsrc + (size_t)row * D + 4 * lane + 256 * j);
            if (COMBINE) { v[j] += load4bf(yc + (size_t)(2 * row) * D + 4 * lane + 256 * j); v[j] += load4bf(yc + (size_t)(2 * row + 1) * D + 4 * lane + 256 * j); }
            ss += (v[j][0] * v[j][0] + v[j][1] * v[j][1]) + (v[j][2] * v[j][2] + v[j][3] * v[j][3]);
        }
        const float rstd = rsqrtf(wave_sum(ss) * (1.0f / D) + RMS_EPS);
#pragma unroll
        for (int j = 0; j < 4; ++j) {
            if (COMBINE && !FINAL) *(f32x4*)(xbuf + (size_t)row * D + 4 * lane + 256 * j) = v[j];
            const f32x4 o = v[j] * rstd * gv[j];
            if (FINAL) *(f32x4*)(outf + (size_t)row * D + 4 * lane + 256 * j) = o;
            else store4bf(h + (size_t)row * D + 4 * lane + 256 * j, o);
        }
    }
}

constexpr int RING_BYTES = 131072;
constexpr int LDSCTL_OFF = RING_BYTES, MISC_OFF = LDSCTL_OFF + 320;
constexpr int MOE_OFF = LDSCTL_OFF + 1024;
constexpr int RT_LOG = LDSCTL_OFF + 2048;
constexpr int RT_HIST = RT_LOG + 64 * 40 * 4;
constexpr int LDS_BYTES = 147456;
static_assert(RT_HIST + 256 <= LDS_BYTES, "LDS map");
__device__ __forceinline__ void router_phase(rsrc_t xr, rsrc_t gr, rsrc_t wgr, rsrc_t wsr, const float* bg, const float* wr, const float* br,
                                             bf16_t* h2, unsigned* cnt, int* slot_tok, float* slot_w, int* slot_asg, float* slot_rs, LAS unsigned char* lds, int tid, int bid, int nblk) {
    const int lane = tid & 63, wid = __builtin_amdgcn_readfirstlane(tid >> 6), kk = lane & 15, rg = lane >> 4;
    if (bid == 0) for (int i = tid; i < D / 2; i += 512) ((unsigned*)(h2 + (size_t)T * D))[i] = 0u;
    for (int idx = tid; idx < 8192; idx += 512) {
        const int k = idx >> 3, q = idx & 7, kk_ = (k & 63) >> 2, e = k & 3, c = k >> 6;
        *(LAS f32x4*)(lds + q * 16384 + c * 1024 + e * 256 + kk_ * 16) = *(const f32x4*)(wr + (size_t)k * NE + 4 * q);
    }
    LAS float* logit = (LAS float*)(lds + RT_LOG); LAS int* hist = (LAS int*)(lds + RT_HIST); LAS int* base = hist + 32;
    __syncthreads();
    for (int rb = bid; rb < T / 64; rb += nblk) {
        const int rl0 = wid * 8 + rg;
        const unsigned vx = (unsigned)(rg * (D * 4) + kk * 16), vh = (unsigned)(rg * (D * 2) + kk * 8), vg = (unsigned)(kk * 16), vw = (unsigned)(kk * 64);
        const unsigned sx0 = (unsigned)(rb * 64 + wid * 8) * (unsigned)(D * 4), sx1 = sx0 + (unsigned)(4 * D * 4);
        const unsigned sh0 = (unsigned)WS_H + (unsigned)(rb * 64 + wid * 8) * (unsigned)(D * 2), sh1 = sh0 + (unsigned)(4 * D * 2);
        float a0[36], a1[36];
#pragma unroll
        for (int i = 0; i < 36; ++i) { a0[i] = 0.f; a1[i] = 0.f; }
        float ss0 = 0.f, ss1 = 0.f;
        f32x4 rxa[3], rxb[3];
#pragma unroll
        for (int j = 0; j < 3; ++j) { rxa[j] = bld4f(xr, vx, sx0 + (unsigned)(256 * j)); rxb[j] = bld4f(xr, vx, sx1 + (unsigned)(256 * j)); }
        f32x4 ngg = bld4f(gr, vg, 0u);
#pragma unroll 1
        for (int c4 = 0; c4 < 18; c4 += 3) {
#pragma unroll
            for (int j = 0; j < 3; ++j) {
                const int c = c4 + j; if (c >= 16) break;
                f32x4 xa = rxa[j], xb = rxb[j]; const f32x4 gg = ngg; f32x4 wgv[4];
#pragma unroll
                for (int e = 0; e < 4; ++e) wgv[e] = bld4f(wgr, vw + (unsigned)(16 * e), (unsigned)(c * 1024));
                const int cx = c + 3 < 16 ? c + 3 : c, cn = c + 1 < 16 ? c + 1 : c;
                rxa[j] = bld4f(xr, vx, sx0 + (unsigned)(256 * cx)); rxb[j] = bld4f(xr, vx, sx1 + (unsigned)(256 * cx));
                ngg = bld4f(gr, vg, (unsigned)(256 * cn));
                ss0 += (xa[0] * xa[0] + xa[1] * xa[1]) + (xa[2] * xa[2] + xa[3] * xa[3]);
                ss1 += (xb[0] * xb[0] + xb[1] * xb[1]) + (xb[2] * xb[2] + xb[3] * xb[3]);
                xa *= gg; xb *= gg;
                bst4bf(wsr, vh, sh0 + (unsigned)(128 * c), xa); bst4bf(wsr, vh, sh1 + (unsigned)(128 * c), xb);
                const LAS unsigned char* wl = lds + c * 1024 + kk * 16;
#pragma unroll
                for (int e = 0; e < 4; ++e) {
#pragma unroll
                    for (int i = 0; i < 4; ++i) { a0[i] += xa[e] * wgv[e][i]; a1[i] += xb[e] * wgv[e][i]; }
#pragma unroll
                    for (int q = 0; q < 8; ++q) { const f32x4 wv = *(const LAS f32x4*)(wl + q * 16384 + e * 256);
#pragma unroll
                        for (int i = 0; i < 4; ++i) { a0[4 + 4 * q + i] += xa[e] * wv[i]; a1[4 + 4 * q + i] += xb[e] * wv[i]; } }
                    asm volatile("" ::: "memory");
                }
            }
        }
#pragma unroll
        for (int o = 1; o < 16; o <<= 1) {
            ss0 += __shfl_xor(ss0, o); ss1 += __shfl_xor(ss1, o);
#pragma unroll
            for (int i = 0; i < 36; ++i) { a0[i] += __shfl_xor(a0[i], o); a1[i] += __shfl_xor(a1[i], o); }
        }
        const float rstd0 = rsqrtf(ss0 * (1.0f / D) + RMS_EPS), rstd1 = rsqrtf(ss1 * (1.0f / D) + RMS_EPS);
        if (kk == 0) {
#pragma unroll
            for (int i = 0; i < 36; ++i) { const float b = i < 4 ? bg[i] : br[i - 4]; logit[rl0 * 40 + i] = a0[i] * rstd0 + b; logit[(rl0 + 4) * 40 + i] = a1[i] * rstd1 + b; }
            logit[rl0 * 40 + 36] = rstd0; logit[(rl0 + 4) * 40 + 36] = rstd1;
        }
        if (tid < 32) hist[tid] = 0;
        asm volatile("s_waitcnt lgkmcnt(0)" ::: "memory"); __syncthreads();
        int e0 = 0, e1 = 0, lr0 = 0, lr1 = 0; float w0 = 0.f, w1 = 0.f;
        if (tid < 64) {
            const LAS float* lp = logit + tid * 40;
            int gi = 0; float gm = lp[0];
#pragma unroll
            for (int i = 1; i < NG; ++i) { const float v = lp[i]; if (v > gm) { gm = v; gi = i; } }
            float gs = 0.f;
#pragma unroll
            for (int i = 0; i < NG; ++i) gs += __expf(lp[i] - gm);
            const float gp = 1.0f / gs;
            const LAS float* ep = lp + 4 + gi * EPG;
            int i0 = 0; float m0 = ep[0];
#pragma unroll
            for (int i = 1; i < EPG; ++i) { const float v = ep[i]; if (v > m0) { m0 = v; i0 = i; } }
            int i1 = -1; float m1 = -3.0e38f;
#pragma unroll
            for (int i = 0; i < EPG; ++i) { const float v = ep[i]; if (i != i0 && v > m1) { m1 = v; i1 = i; } }
            const float ex = __expf(m1 - m0); w0 = gp / (1.0f + ex); w1 = gp * ex / (1.0f + ex);
            e0 = gi * EPG + i0; e1 = gi * EPG + i1;
            lr0 = __hip_atomic_fetch_add((int*)(hist + e0), 1, __ATOMIC_RELAXED, __HIP_MEMORY_SCOPE_WORKGROUP);
            lr1 = __hip_atomic_fetch_add((int*)(hist + e1), 1, __ATOMIC_RELAXED, __HIP_MEMORY_SCOPE_WORKGROUP);
        }
        asm volatile("s_waitcnt lgkmcnt(0)" ::: "memory"); __syncthreads();
        if (tid < 32) { const int n = hist[tid]; base[tid] = n > 0 ? (int)atomicAdd(cnt + tid, (unsigned)n) : 0; }
        asm volatile("s_waitcnt vmcnt(0) lgkmcnt(0)" ::: "memory"); __syncthreads();
        if (tid < 64) {
            const int row = rb * 64 + tid, s0 = e0 * CAP + base[e0] + lr0, s1 = e1 * CAP + base[e1] + lr1;
            const float rs = logit[tid * 40 + 36];
            slot_tok[s0] = row; slot_w[s0] = w0; slot_asg[s0] = 2 * row; slot_rs[s0] = rs;
            slot_tok[s1] = row; slot_w[s1] = w1; slot_asg[s1] = 2 * row + 1; slot_rs[s1] = rs;
        }
        __syncthreads();
    }
}

__device__ __forceinline__ void midA_phase(const bf16_t* QA, bf16_t* BA, const float* cw  , int bid, int nblk) {
    const int nthr = blockDim.x;
    for (int idx = bid * nthr + threadIdx.x; idx < T * (D / 8); idx += nblk * nthr) {
        const int t = idx >> 7, c = (idx & 127) * 8, s = t & (SEQ - 1);
        const u32x4 z = {0u, 0u, 0u, 0u};
        const u32x4 q1 = *(const u32x4*)(QA + (size_t)t * D + c);
        u32x4 q0 = *(const u32x4*)(QA + (size_t)(s > 0 ? t - 1 : t) * D + c);
        u32x4 q2 = *(const u32x4*)(QA + (size_t)(s < SEQ - 1 ? t + 1 : t) * D + c);
        q0 = s > 0 ? q0 : z; q2 = s < SEQ - 1 ? q2 : z;
        const u32x4 bb = *(const u32x4*)(BA + (size_t)t * D + c);
        u32x4 o;
#pragma unroll
        for (int j = 0; j < 4; ++j) {
            const int c0 = c + 2 * j;
            const float lo = bf_lo(bb[j]) * (cw[c0] * bf_lo(q0[j]) + cw[D + c0] * bf_lo(q1[j]) + cw[2 * D + c0] * bf_lo(q2[j]));
            const float hi = bf_hi(bb[j]) * (cw[c0 + 1] * bf_hi(q0[j]) + cw[D + c0 + 1] * bf_hi(q1[j]) + cw[2 * D + c0 + 1] * bf_hi(q2[j]));
            o[j] = cvt_pk_bf16(lo, hi);
        }
        *(u32x4*)(BA + (size_t)t * D + c) = o;
    }
}
__device__ __forceinline__ void midB_conv_phase(const bf16_t* ZB, bf16_t* CB, const float* cw  , int bid, int nblk) {
    for (int cp = threadIdx.x; cp < D / 2; cp += blockDim.x) {
        f32x2 w[31];
#pragma unroll
        for (int j = 0; j < 31; ++j) w[j] = *(const f32x2*)(cw + j * D + 2 * cp);
        for (int tg = bid; tg < T / 16; tg += nblk) {
            const int t0 = tg * 16, s0 = t0 & (SEQ - 1);
            f32x2 acc[16];
#pragma unroll
            for (int o = 0; o < 16; ++o) acc[o] = (f32x2){0.f, 0.f};
#pragma unroll
            for (int i = 0; i < 46; ++i) {
                const int s = s0 - 15 + i;
                const bool ok = (s >= 0 && s < SEQ);
                unsigned xv = *(const unsigned*)(ZB + (size_t)(ok ? t0 - 15 + i : t0) * D + 2 * cp);
                xv = ok ? xv : 0u;
                const f32x2 x = {bf_lo(xv), bf_hi(xv)};
#pragma unroll
                for (int o = 0; o < 16; ++o) { const int j = i - o; if (j >= 0 && j < 31) acc[o] += w[j] * x; }
            }
#pragma unroll
            for (int o = 0; o < 16; ++o) *(unsigned*)(CB + (size_t)(t0 + o) * D + 2 * cp) = cvt_pk_bf16(acc[o][0], acc[o][1]);
        }
    }
}
__device__ __forceinline__ void row16_load(const bf16_t* rowp, int lane, float (&x)[16]) {
    const u32x4 a = *(const u32x4*)(rowp + 8 * lane), b = *(const u32x4*)(rowp + 512 + 8 * lane);
#pragma unroll
    for (int j = 0; j < 4; ++j) { x[2 * j] = bf_lo(a[j]); x[2 * j + 1] = bf_hi(a[j]); x[8 + 2 * j] = bf_lo(b[j]); x[8 + 2 * j + 1] = bf_hi(b[j]); }
}
__device__ __forceinline__ void row16_stats(const float (&x)[16], float& mean, float& rstd) {
    float s = 0.f;
#pragma unroll
    for (int j = 0; j < 16; ++j) s += x[j];
    mean = wave_sum(s) * (1.0f / D);
    float q = 0.f;
#pragma unroll
    for (int j = 0; j < 16; ++j) { const float d = x[j] - mean; q += d * d; }
    rstd = rsqrtf(wave_sum(q) * (1.0f / D) + LN_EPS);
}
__device__ __forceinline__ void midB_ln_phase(bf16_t* CB, const float* g, const float* b, int bid, int nblk) {
    const int lane = threadIdx.x & 63, wave = threadIdx.x >> 6, nw = blockDim.x >> 6;
    float gg[16], bb[16];
#pragma unroll
    for (int j = 0; j < 8; ++j) { gg[j] = g[8 * lane + j]; gg[8 + j] = g[512 + 8 * lane + j]; bb[j] = b[8 * lane + j]; bb[8 + j] = b[512 + 8 * lane + j]; }
    for (int row = bid * nw + wave; row < T; row += nblk * nw) {
        float x[16], mean, rstd; row16_load(CB + (size_t)row * D, lane, x); row16_stats(x, mean, rstd);
        u32x4 o0, o1;
#pragma unroll
        for (int j = 0; j < 4; ++j) {
            o0[j] = cvt_pk_bf16(siluf_((x[2 * j] - mean) * rstd * gg[2 * j] + bb[2 * j]), siluf_((x[2 * j + 1] - mean) * rstd * gg[2 * j + 1] + bb[2 * j + 1]));
            o1[j] = cvt_pk_bf16(siluf_((x[8 + 2 * j] - mean) * rstd * gg[8 + 2 * j] + bb[8 + 2 * j]), siluf_((x[8 + 2 * j + 1] - mean) * rstd * gg[8 + 2 * j + 1] + bb[8 + 2 * j + 1]));
        }
        *(u32x4*)(CB + (size_t)row * D + 8 * lane) = o0; *(u32x4*)(CB + (size_t)row * D + 512 + 8 * lane) = o1;
    }
}
__device__ __forceinline__ void midC_stats_phase(const bf16_t* V, float* stat, int bid, int nblk) {
    const int lane = threadIdx.x & 63, wave = threadIdx.x >> 6, nw = blockDim.x >> 6;
    for (int row = bid * nw + wave; row < T; row += nblk * nw) {
        float x[16], mean, rstd; row16_load(V + (size_t)row * D, lane, x); row16_stats(x, mean, rstd);
        if (lane == 0) *(f32x2*)(stat + 2 * row) = (f32x2){mean, rstd};
    }
}
#ifndef PROBE_MID
#define PROBE_MID 0
#endif
constexpr int MC_LD = 272;
constexpr int MID_SA = 0, MID_SB = 64 * MC_LD, MID_LDS = MID_SB + 128 * MC_LD;
constexpr int MID_STAT = 131072 + 2048;
__device__ __forceinline__ void mid_phase(rsrc_t wsr, unsigned char* wsb, const bf16_t* V,
                                          const float* cwa  , const float* cwb  , const float* lnbg, const float* lnbb, const float* lncg, const float* lncb,
                                          const float* Ws  , const float* bs  , const float* rowsum  , LAS unsigned char* lds, int tid, int bid, int nblk, unsigned long long& mpt) {
    const int lane = tid & 63, wid = __builtin_amdgcn_readfirstlane(tid >> 6), fr = lane & 15, fq = lane >> 4;
    unsigned long long mp0 = 0ull; (void)mp0;
#define MPB(j) do { if ((PROBE_MID >> (j)) & 1) { __syncthreads(); mp0 = __builtin_amdgcn_s_memrealtime(); } } while (0)
#define MPE(j) do { if ((PROBE_MID >> (j)) & 1) { asm volatile("s_waitcnt vmcnt(0) lgkmcnt(0)" ::: "memory"); __syncthreads(); mpt += __builtin_amdgcn_s_memrealtime() - mp0; } } while (0)
    LAS float* statL = (LAS float*)(lds + MID_STAT); LAS unsigned char* SA = lds + MID_SA; LAS unsigned char* SB = lds + MID_SB;
    const u32x4 z4 = {0u, 0u, 0u, 0u};
    for (int tile = bid; tile < T / 64; tile += nblk) {
        const int t0 = tile * 64, ch0 = (tile >> 1) * 128, half = tile & 1;
        const bf16_t* QA = (const bf16_t*)(wsb + WS_QA); bf16_t* BA = (bf16_t*)(wsb + WS_BA);
        MPB(0);
        {
            int tz = tid; asm volatile("" : "+v"(tz));
            const int c = (tz & 127) * 8, r0 = tz >> 7;
            float w0[8], w1[8], w2[8];
#pragma unroll
            for (int j = 0; j < 8; ++j) { w0[j] = cwa[c + j]; w1[j] = cwa[D + c + j]; w2[j] = cwa[2 * D + c + j]; }
#pragma unroll 1
            for (int k4 = 0; k4 < 16; k4 += 4) {
                u32x4 q0[4], q1[4], q2[4], bb[4];
#pragma unroll
                for (int u = 0; u < 4; ++u) {
                    const int t = t0 + r0 + 4 * (k4 + u), sq = t & (SEQ - 1);
                    q1[u] = *(const u32x4*)(QA + (size_t)t * D + c);
                    q0[u] = *(const u32x4*)(QA + (size_t)(sq > 0 ? t - 1 : t) * D + c);
                    q2[u] = *(const u32x4*)(QA + (size_t)(sq < SEQ - 1 ? t + 1 : t) * D + c);
                    bb[u] = *(const u32x4*)(BA + (size_t)t * D + c);
                }
#pragma unroll
                for (int u = 0; u < 4; ++u) {
                    const int t = t0 + r0 + 4 * (k4 + u), sq = t & (SEQ - 1);
                    const u32x4 a0 = sq > 0 ? q0[u] : z4, a2 = sq < SEQ - 1 ? q2[u] : z4;
                    u32x4 o;
#pragma unroll
                    for (int e = 0; e < 4; ++e) {
                        const float lo = bf_lo(bb[u][e]) * (w0[2 * e] * bf_lo(a0[e]) + w1[2 * e] * bf_lo(q1[u][e]) + w2[2 * e] * bf_lo(a2[e]));
                        const float hi = bf_hi(bb[u][e]) * (w0[2 * e + 1] * bf_hi(a0[e]) + w1[2 * e + 1] * bf_hi(q1[u][e]) + w2[2 * e + 1] * bf_hi(a2[e]));
                        o[e] = cvt_pk_bf16(lo, hi);
                    }
                    *(u32x4*)(BA + (size_t)t * D + c) = o;
                }
            }
        }
        MPE(0); MPB(1);
        {
            int cp = tid; asm volatile("" : "+v"(cp) :: "memory");
            f32x2 w[31];
#pragma unroll
            for (int j = 0; j < 31; ++j) w[j] = *(const f32x2*)(cwb + j * D + 2 * cp);
            const unsigned zrow0 = (unsigned)(t0 + 2 * ZPAD * (t0 >= SEQ ? 1 : 0));
            for (int g = 0; g < 4; ++g) {
                const unsigned sb = (unsigned)WS_ZB + (zrow0 + 16u * (unsigned)g) * (unsigned)(D * 2);
                f32x2 acc[16];
#pragma unroll
                for (int o = 0; o < 16; ++o) acc[o] = (f32x2){0.f, 0.f};
#pragma unroll
                for (int ib = 0; ib < 48; ib += 16) {
                    unsigned xv[16];
#pragma unroll
                    for (int q = 0; q < 16; ++q) if (ib + q < 46) xv[q] = __builtin_amdgcn_raw_buffer_load_b32(wsr, (unsigned)(4 * cp), sb + (unsigned)((ib + q) * D * 2), 0);
#pragma unroll
                    for (int q = 0; q < 16; ++q) if (ib + q < 46) {
                        const int i = ib + q; const f32x2 x = {bf_lo(xv[q]), bf_hi(xv[q])};
#pragma unroll
                        for (int o = 0; o < 16; ++o) { const int j = i - o; if (j >= 0 && j < 31) acc[o] += w[j] * x; }
                    }
                }
#pragma unroll
                for (int o = 0; o < 16; ++o) *(LAS unsigned*)(lds + (16 * g + o) * (D * 2) + 4 * cp) = cvt_pk_bf16(acc[o][0], acc[o][1]);
            }
        }
        MPE(1); MPB(2);
        if (tid < 128) {
            const unsigned so = (unsigned)WS_PART + (unsigned)ch0 * 256u;
            u32x4 pp[16];
#pragma unroll
            for (int j = 0; j < 16; ++j) pp[j] = __builtin_amdgcn_raw_buffer_load_b128(wsr, (unsigned)(tid * 256 + j * 16), so, 0);
            float sm = 0.f, sq = 0.f;
#pragma unroll
            for (int j = 0; j < 16; ++j) { sm += __uint_as_float(pp[j].x); sq += __uint_as_float(pp[j].y); sm += __uint_as_float(pp[j].z); sq += __uint_as_float(pp[j].w); }
            const float mean = sm * (1.0f / D), var = sq * (1.0f / D) - mean * mean;
            statL[2 * tid] = mean; statL[2 * tid + 1] = rsqrtf(fmaxf(var, 0.f) + LN_EPS);
        }
        asm volatile("s_waitcnt vmcnt(0) lgkmcnt(0)" ::: "memory"); __syncthreads();
        {
            int ld_ = lane; asm volatile("" : "+v"(ld_));
            float gg[16], bb[16];
#pragma unroll
            for (int j = 0; j < 8; ++j) { gg[j] = lnbg[8 * ld_ + j]; gg[8 + j] = lnbg[512 + 8 * ld_ + j]; bb[j] = lnbb[8 * ld_ + j]; bb[8 + j] = lnbb[512 + 8 * ld_ + j]; }
#pragma unroll 1
            for (int rq = 0; rq < 8; rq += 4) {
                float x[4][16];
#pragma unroll
                for (int j = 0; j < 4; ++j) { const u32x4 a = *(const LAS u32x4*)(lds + (wid * 8 + rq + j) * (D * 2) + lane * 16), b = *(const LAS u32x4*)(lds + (wid * 8 + rq + j) * (D * 2) + 1024 + lane * 16);
#pragma unroll
                    for (int e = 0; e < 4; ++e) { x[j][2 * e] = bf_lo(a[e]); x[j][2 * e + 1] = bf_hi(a[e]); x[j][8 + 2 * e] = bf_lo(b[e]); x[j][8 + 2 * e + 1] = bf_hi(b[e]); } }
#pragma unroll
                for (int j = 0; j < 4; ++j) {
                    float mean, rstd; row16_stats(x[j], mean, rstd);
                    u32x4 o0, o1;
#pragma unroll
                    for (int e = 0; e < 4; ++e) {
                        o0[e] = cvt_pk_bf16(siluf_((x[j][2 * e] - mean) * rstd * gg[2 * e] + bb[2 * e]), siluf_((x[j][2 * e + 1] - mean) * rstd * gg[2 * e + 1] + bb[2 * e + 1]));
                        o1[e] = cvt_pk_bf16(siluf_((x[j][8 + 2 * e] - mean) * rstd * gg[8 + 2 * e] + bb[8 + 2 * e]), siluf_((x[j][8 + 2 * e + 1] - mean) * rstd * gg[8 + 2 * e + 1] + bb[8 + 2 * e + 1]));
                    }
                    const unsigned so = (unsigned)WS_CB + (unsigned)(t0 + wid * 8 + rq + j) * (unsigned)(D * 2);
                    __builtin_amdgcn_raw_buffer_store_b128(o0, wsr, (unsigned)(lane * 16), so, 0); __builtin_amdgcn_raw_buffer_store_b128(o1, wsr, (unsigned)(lane * 16 + 1024), so, 0);
                }
            }
        }
        asm volatile("s_waitcnt lgkmcnt(0)" ::: "memory"); __syncthreads();
        MPE(2); MPB(3);
        {
            const int wr = wid >> 2, wc = wid & 3;
            int te = tid; asm volatile("" : "+v"(te));
            f32x4 ra[2][2]; u32x4 rv[2][2]; u32x2 ru[2][2]; f32x4 rg[2], rbe[2]; float rs[2], rbi[2];
#define MID_ISSUE(h) do { \
_Pragma("unroll") \
                for (int i = 0; i < 2; ++i) { const int idx = te + 512 * i, pr = idx >> 4, q8 = idx & 15; const float* sp = Ws + ((size_t)(h) * 128 + half * 64 + pr) * 128 + q8 * 8; ra[i][0] = *(const f32x4*)sp; ra[i][1] = *(const f32x4*)(sp + 4); } \
_Pragma("unroll") \
                for (int i = 0; i < 2; ++i) { const int idx = te + 512 * i, qp = idx & 63, c8 = idx >> 6; const bf16_t* vp = V + (size_t)(ch0 + 2 * qp) * D + (h) * 128 + c8 * 8; rv[i][0] = *(const u32x4*)vp; rv[i][1] = *(const u32x4*)(vp + D); } \
_Pragma("unroll") \
                for (int m = 0; m < 2; ++m) { rs[m] = rowsum[(h) * 128 + half * 64 + wr * 32 + m * 16 + fr]; rbi[m] = bs[(h) * 128 + half * 64 + wr * 32 + m * 16 + fr]; \
_Pragma("unroll") \
                    for (int nn = 0; nn < 2; ++nn) ru[m][nn] = __builtin_amdgcn_raw_buffer_load_b64(wsr, (unsigned)(fr * (D * 2) + fq * 8), (unsigned)WS_U + (unsigned)(t0 + wr * 32 + m * 16) * (unsigned)(D * 2) + (unsigned)((h) * 128 + wc * 32 + nn * 16) * 2u, 0); } \
_Pragma("unroll") \
                for (int nn = 0; nn < 2; ++nn) { rg[nn] = *(const f32x4*)(lncg + (h) * 128 + wc * 32 + nn * 16 + 4 * fq); rbe[nn] = *(const f32x4*)(lncb + (h) * 128 + wc * 32 + nn * 16 + 4 * fq); } \
             } while (0)
            MID_ISSUE(0);
#pragma unroll 1
            for (int h = 0; h < NHC; ++h) {
#pragma unroll
                for (int i = 0; i < 2; ++i) { const int idx = te + 512 * i, pr = idx >> 4, q8 = idx & 15;
                    u32x4 o; o.x = cvt_pk_bf16(ra[i][0][0], ra[i][0][1]); o.y = cvt_pk_bf16(ra[i][0][2], ra[i][0][3]); o.z = cvt_pk_bf16(ra[i][1][0], ra[i][1][1]); o.w = cvt_pk_bf16(ra[i][1][2], ra[i][1][3]);
                    *(LAS u32x4*)(SA + pr * MC_LD + q8 * 16) = o; }
#pragma unroll
                for (int i = 0; i < 2; ++i) { const int idx = te + 512 * i, qp = idx & 63, c8 = idx >> 6;
                    const f32x4 st = *(const LAS f32x4*)(statL + 4 * qp);
#pragma unroll
                    for (int j = 0; j < 4; ++j) {
                        *(LAS unsigned*)(SB + (c8 * 8 + 2 * j) * MC_LD + qp * 4) = cvt_pk_bf16((bf_lo(rv[i][0][j]) - st[0]) * st[1], (bf_lo(rv[i][1][j]) - st[2]) * st[3]);
                        *(LAS unsigned*)(SB + (c8 * 8 + 2 * j + 1) * MC_LD + qp * 4) = cvt_pk_bf16((bf_hi(rv[i][0][j]) - st[0]) * st[1], (bf_hi(rv[i][1][j]) - st[2]) * st[3]);
                    } }
                u32x2 uc[2][2]; f32x4 gc[2], bc[2]; float sc[2], bic[2];
#pragma unroll
                for (int m = 0; m < 2; ++m) { sc[m] = rs[m]; bic[m] = rbi[m]; gc[m] = rg[m]; bc[m] = rbe[m];
#pragma unroll
                    for (int nn = 0; nn < 2; ++nn) uc[m][nn] = ru[m][nn]; }
                asm volatile("s_waitcnt lgkmcnt(0)" ::: "memory"); __syncthreads();
                if (h + 1 < NHC) MID_ISSUE(h + 1);
                f32x4 acc[2][2];
#pragma unroll
                for (int m = 0; m < 2; ++m)
#pragma unroll
                    for (int nn = 0; nn < 2; ++nn) acc[m][nn] = (f32x4){0.f, 0.f, 0.f, 0.f};
#pragma unroll
                for (int ks = 0; ks < 4; ++ks) {
                    bf16x8 a[2], b[2];
#pragma unroll
                    for (int m = 0; m < 2; ++m) a[m] = *(const LAS bf16x8*)(SA + (wr * 32 + m * 16 + fr) * MC_LD + ks * 64 + fq * 16);
#pragma unroll
                    for (int nn = 0; nn < 2; ++nn) b[nn] = *(const LAS bf16x8*)(SB + (wc * 32 + nn * 16 + fr) * MC_LD + ks * 64 + fq * 16);
#pragma unroll
                    for (int m = 0; m < 2; ++m)
#pragma unroll
                        for (int nn = 0; nn < 2; ++nn) acc[m][nn] = __builtin_amdgcn_mfma_f32_16x16x32_bf16(b[nn], a[m], acc[m][nn], 0, 0, 0);
                }
#pragma unroll
                for (int m = 0; m < 2; ++m)
#pragma unroll
                    for (int nn = 0; nn < 2; ++nn) {
                        const f32x4 uu = {bf_lo(uc[m][nn].x), bf_hi(uc[m][nn].x), bf_lo(uc[m][nn].y), bf_hi(uc[m][nn].y)};
                        const f32x4 o = gc[nn] * acc[m][nn] + (bc[nn] * sc[m] + bic[m]);
                        bst4bf(wsr, (unsigned)(fr * (D * 2) + fq * 8), (unsigned)WS_U + (unsigned)(t0 + wr * 32 + m * 16) * (unsigned)(D * 2) + (unsigned)(h * 128 + wc * 32 + nn * 16) * 2u, uu * o);
                    }
                asm volatile("s_waitcnt lgkmcnt(0)" ::: "memory"); __syncthreads();
            }
        }
        MPE(3);
    }
}

namespace pg8 {
constexpr int BM = 256, BK = 64, HALF = 128, HTB = HALF * BK * 2  , STAGE_BYTES = 8 * HTB, NXCD = 8, WGM = 8;
__device__ __forceinline__ int lds_byte(int r, int c) { const int st = (r >> 4) * 2 + (c >> 5), rr = r & 15, cc = c & 31, ob = rr * 64 + cc * 2; return st * 1024 + (ob ^ (((ob >> 9) & 1) << 5)); }
__device__ __forceinline__ void stage_rc(int b, int& R, int& C) { const int st = b / 1024, sb = b % 1024, swz = sb ^ (((sb >> 9) & 1) << 5); R = (st >> 1) * 16 + swz / 64; C = (st & 1) * 32 + (swz % 64) / 2; }
struct Unit { int pm, pn, e, it, ne; };
struct StaticOrder {
    int nM, nN, nwg, G, c;
    __device__ __forceinline__ void init(int M, int N, int G_, int c_) { nM = M / BM; nN = N / BM; nwg = nM * nN; G = G_; c = c_; }
    __device__ __forceinline__ bool next(int i, int& pm, int& pn) const {
        const long L = (long)i * G + c; if (L >= nwg) return false;
        int wgid = (int)L; { const int q = nwg / NXCD, r = nwg % NXCD, xcd = wgid % NXCD, off = wgid / NXCD; wgid = (xcd < r ? xcd * (q + 1) : r * (q + 1) + (xcd - r) * q) + off; }
        const int nig = WGM * nN, gid = wgid / nig, fm = gid * WGM, gsz = (nM - fm) < WGM ? (nM - fm) : WGM;
        pm = fm + ((wgid % nig) % gsz); pn = (wgid % nig) / gsz; return true;
    }
};
template <int NGRP, class Epi> __device__ __forceinline__ void run_epi(const Epi& E, f32x4 (&acc)[2][2][4][2], const Unit& u, int wr, int wc, int fr, int fq) {
#pragma unroll
    for (int ai = 0; ai < 2; ++ai)
#pragma unroll
        for (int mb = 0; mb < 4; mb += NGRP) {
            typename Epi::Regs R[NGRP][2];
#pragma unroll
            for (int g = 0; g < NGRP; ++g)
#pragma unroll
                for (int bj = 0; bj < 2; ++bj) E.pre(u, u.pm * BM + ai * HALF + wr * 64 + (mb + g) * 16, u.pn * BM + bj * HALF + wc * 32, fr, fq, R[g][bj]);
#pragma unroll
            for (int g = 0; g < NGRP; ++g)
#pragma unroll
                for (int bj = 0; bj < 2; ++bj) E.post(u, u.pm * BM + ai * HALF + wr * 64 + (mb + g) * 16, u.pn * BM + bj * HALF + wc * 32, fr, fq, R[g][bj], acc[ai][bj][mb + g][0], acc[ai][bj][mb + g][1]);
            asm volatile("" ::: "memory");
        }
}
template <class Prob, bool ALIGN_EPI>
__device__ __forceinline__ void gemm_phase(LAS unsigned char* lds, const Prob& P, int tid) {
    const int wid = __builtin_amdgcn_readfirstlane(tid >> 6), lane = tid & 63, wr = wid >> 2, wc = wid & 3, fr = lane & 15, fq = lane >> 4;
    const int K = P.K, nt = K / BK;
    unsigned voffA[2], voffB[2]; int sR[2], sC[2];
#pragma unroll
    for (int i = 0; i < 2; ++i) { stage_rc(tid * 16 + i * 8192, sR[i], sC[i]); voffA[i] = (unsigned)(sR[i] * K + sC[i]) * 2u; voffB[i] = voffA[i]; }
    const size_t kstep = (size_t)(BK * 2);
    const size_t hstep = (size_t)HALF * K * 2;
    const unsigned ldsw = (unsigned)wid * 1024u;
    const int aoff = lds_byte(wr * 64 + fr, fq * 8), boff = lds_byte(wc * 32 + fr, fq * 8);
#define PG8_SA(b, h) (((b) * 2 + (h)) * HTB)
#define PG8_SB(b, h) ((4 + (b) * 2 + (h)) * HTB)
#define PG8_STAGE(bufoff, gbase, voff) do { _Pragma("unroll") for (int _i = 0; _i < 2; ++_i) \
        __builtin_amdgcn_global_load_lds((const unsigned*)((const char*)(gbase) + (voff)[_i]), (LAS unsigned*)(lds + (bufoff) + ldsw + _i * 8192), 16, 0, 0); } while (0)
#define PG8_STAGE_A(bufoff, ptr, h, go) do { if constexpr (Prob::GATHER) PG8_STAGE(bufoff, ptr, (go)[h]); else PG8_STAGE(bufoff, (ptr) + (h) * hstep, voffA); } while (0)
#define PG8_LDA(dst, b, h) do { _Pragma("unroll") for (int m = 0; m < 4; ++m) _Pragma("unroll") for (int k = 0; k < 2; ++k) dst[m][k] = *(const LAS bf16x8*)(lds + PG8_SA(b, h) + aoff + m * 2048 + k * 1024); } while (0)
#define PG8_LDB(dst, b, h) do { _Pragma("unroll") for (int n = 0; n < 2; ++n) _Pragma("unroll") for (int k = 0; k < 2; ++k) dst[n][k] = *(const LAS bf16x8*)(lds + PG8_SB(b, h) + boff + n * 2048 + k * 1024); } while (0)
#define PG8_MMA(ai, bj, At, Bt) do { __builtin_amdgcn_s_setprio(1); _Pragma("unroll") for (int m = 0; m < 4; ++m) _Pragma("unroll") for (int n = 0; n < 2; ++n) _Pragma("unroll") for (int k = 0; k < 2; ++k) \
        acc[ai][bj][m][n] = __builtin_amdgcn_mfma_f32_16x16x32_bf16(Bt[n][k], At[m][k], acc[ai][bj][m][n], 0, 0, 0); __builtin_amdgcn_s_setprio(0); } while (0)
#define PG8_WAIT_V(n) asm volatile("s_waitcnt vmcnt(" #n ")" ::: "memory")
#define PG8_WAIT_L(n) asm volatile("s_waitcnt lgkmcnt(" #n ")" ::: "memory")
#define PG8_BAR __builtin_amdgcn_s_barrier()
#define PG8_SCHED __builtin_amdgcn_sched_barrier(0)
    Unit cur, nxt; int ui = 0;
    if (!P.next(0, cur)) return;
    f32x4 acc[2][2][4][2];
#pragma unroll
    for (int a = 0; a < 2; ++a)
#pragma unroll
        for (int b = 0; b < 2; ++b)
#pragma unroll
            for (int m = 0; m < 4; ++m)
#pragma unroll
                for (int n = 0; n < 2; ++n) acc[a][b][m][n] = (f32x4){0.f, 0.f, 0.f, 0.f};
    bf16x8 At[4][2], B0[2][2], B1[2][2];
    const char* cA = P.abase(cur); const char* cB = P.bbase(cur);
    unsigned cgo[2][2] = {{0u, 0u}, {0u, 0u}}, ngo[2][2] = {{0u, 0u}, {0u, 0u}};
    if constexpr (Prob::GATHER) P.goffs(cur, sR, sC, cgo);
    PG8_STAGE(PG8_SB(0, 0), cB, voffB); PG8_STAGE(PG8_SB(0, 1), cB + hstep, voffB); PG8_STAGE_A(PG8_SA(0, 0), cA, 0, cgo); PG8_STAGE_A(PG8_SA(0, 1), cA, 1, cgo);
    if (wr == 1) PG8_BAR;
    PG8_WAIT_V(2); PG8_BAR;
    PG8_STAGE(PG8_SB(1, 0), cB + kstep, voffB); PG8_STAGE_A(PG8_SA(1, 0), cA + kstep, 0, cgo); PG8_STAGE(PG8_SB(1, 1), cB + hstep + kstep, voffB);
    PG8_WAIT_V(6); PG8_BAR;
    for (;;) {
        const bool has_next = P.next(ui + 1, nxt);
        const char* nA = has_next ? P.abase(nxt) : cA; const char* nB = has_next ? P.bbase(nxt) : cB;
        if constexpr (Prob::GATHER) {
            if (has_next) P.goffs(nxt, sR, sC, ngo);
            else {
#pragma unroll
                for (int h = 0; h < 2; ++h)
#pragma unroll
                    for (int i = 0; i < 2; ++i) ngo[h][i] = cgo[h][i]; }
        }
        for (int t = 0; t < nt; t += 2) {
            const bool last = (t == nt - 2);
            const char* a1 = cA + (size_t)(t + 1) * kstep;
            const char* a2 = last ? nA : cA + (size_t)(t + 2) * kstep; const char* b2 = last ? nB : cB + (size_t)(t + 2) * kstep;
            const char* a3 = a2 + kstep; const char* b3 = b2 + kstep;
            unsigned g2[2][2];
#pragma unroll
            for (int h = 0; h < 2; ++h)
#pragma unroll
                for (int i = 0; i < 2; ++i) g2[h][i] = last ? ngo[h][i] : cgo[h][i];
            PG8_LDB(B0, 0, 0); PG8_LDB(B1, 0, 1); PG8_SCHED; PG8_LDA(At, 0, 0); PG8_STAGE_A(PG8_SA(1, 1), a1, 1, cgo);
            PG8_WAIT_V(8); PG8_WAIT_L(0); PG8_BAR; PG8_MMA(0, 0, At, B0); PG8_MMA(0, 1, At, B1); PG8_BAR; PG8_SCHED;
            PG8_LDA(At, 0, 1); PG8_STAGE(PG8_SB(0, 0), b2, voffB); PG8_STAGE(PG8_SB(0, 1), b2 + hstep, voffB); PG8_STAGE_A(PG8_SA(0, 0), a2, 0, g2);
            PG8_WAIT_V(8); PG8_WAIT_L(0); PG8_BAR; PG8_MMA(1, 0, At, B0); PG8_MMA(1, 1, At, B1); PG8_BAR; PG8_SCHED;
            PG8_LDB(B0, 1, 0); PG8_LDB(B1, 1, 1); PG8_SCHED; PG8_LDA(At, 1, 0); PG8_STAGE_A(PG8_SA(0, 1), a2, 1, g2);
            PG8_WAIT_V(8); PG8_WAIT_L(0); PG8_BAR; PG8_MMA(0, 0, At, B0); PG8_MMA(0, 1, At, B1); PG8_BAR; PG8_SCHED;
            PG8_LDA(At, 1, 1); PG8_STAGE(PG8_SB(1, 0), b3, voffB); PG8_STAGE(PG8_SB(1, 1), b3 + hstep, voffB); PG8_STAGE_A(PG8_SA(1, 0), a3, 0, g2);
            PG8_WAIT_V(8); PG8_WAIT_L(0); PG8_BAR; PG8_MMA(1, 0, At, B0); PG8_MMA(1, 1, At, B1); PG8_BAR; PG8_SCHED;
        }
        if constexpr (ALIGN_EPI) { if (wr == 0) PG8_BAR; }
        P.epi(acc, cur, wr, wc, fr, fq);
        if (!has_next) break;
        if (!(Prob::CHAIN && P.chain(cur)))
#pragma unroll
        for (int a = 0; a < 2; ++a)
#pragma unroll
            for (int b = 0; b < 2; ++b)
#pragma unroll
                for (int m = 0; m < 4; ++m)
#pragma unroll
                    for (int n = 0; n < 2; ++n) acc[a][b][m][n] = (f32x4){0.f, 0.f, 0.f, 0.f};
        cur = nxt; cA = nA; cB = nB; ++ui;
        if constexpr (Prob::GATHER) {
#pragma unroll
            for (int h = 0; h < 2; ++h)
#pragma unroll
                for (int i = 0; i < 2; ++i) cgo[h][i] = ngo[h][i]; }
        if constexpr (ALIGN_EPI) { if (wr == 1) PG8_BAR; }
    }
    PG8_WAIT_V(0);
    if constexpr (!ALIGN_EPI) { if (wr == 0) PG8_BAR; }
    PG8_BAR;
#undef PG8_SA
#undef PG8_SB
#undef PG8_STAGE
#undef PG8_STAGE_A
#undef PG8_LDA
#undef PG8_LDB
#undef PG8_MMA
#undef PG8_WAIT_V
#undef PG8_WAIT_L
#undef PG8_BAR
#undef PG8_SCHED
}
}
using pg8::Unit;

constexpr size_t TSTEP_D = (size_t)256 * D * 2;
__device__ __forceinline__ int pcu(int cu) { return 32 * (cu >> 6) + 16 * ((cu >> 5) & 1); }
struct ProbInProj {
    static constexpr bool GATHER = false, CHAIN = false; __device__ __forceinline__ bool chain(const Unit&) const { return false; }
    const bf16_t* A; const bf16_t* Bt; int K; pg8::StaticOrder S; rsrc_t wsr;
    __device__ __forceinline__ bool next(int i, Unit& u) const { int pm, pn; if (!S.next(i, pm, pn)) return false; u.pm = pm; u.pn = pn; u.e = 0; u.it = 0; u.ne = 0; return true; }
    __device__ __forceinline__ const char* abase(const Unit& u) const { return (const char*)A + (size_t)u.pm * TSTEP_D; }
    __device__ __forceinline__ const char* bbase(const Unit& u) const { return (const char*)Bt + (size_t)u.pn * TSTEP_D; }
    __device__ __forceinline__ void goffs(const Unit&, const int (&)[2], const int (&)[2], unsigned (&)[2][2]) const {}
    struct Regs {};
    __device__ __forceinline__ void pre(const Unit&, int, int, int, int, Regs&) const {}
    __device__ __forceinline__ void post(const Unit&, int ru, int cu, int fr, int fq, const Regs&, f32x4 va, f32x4 vb) const {
        const unsigned v1 = (unsigned)(fr * (D * 2) + fq * 8), row1 = (unsigned)ru * (unsigned)(D * 2);
        if (cu < 2048) bst4bf(wsr, v1, (unsigned)WS_QA + row1 + (unsigned)pcu(cu) * 2u, va * vb);
        else if (cu < 3072) { const unsigned so = (unsigned)WS_BA + row1 + (unsigned)(cu - 2048) * 2u; bst4bf(wsr, v1, so, va); bst4bf(wsr, v1 + 32u, so, vb); }
        else if (cu < 5120) { const unsigned zr = (unsigned)(ru + ZPAD + 2 * ZPAD * (ru >= SEQ ? 1 : 0)) * (unsigned)(D * 2); bst4bf(wsr, v1, (unsigned)WS_ZB + zr + (unsigned)pcu(cu - 3072) * 2u, va * sig4(vb)); }
        else if (cu < 7168) { const int cc = cu - 5120; const unsigned so = (cc < 1024 ? (unsigned)WS_U + (unsigned)cc * 2u : (unsigned)WS_V + (unsigned)(cc - 1024) * 2u) + row1;
            const f32x4 ga = gelu4(va), gb = gelu4(vb); bst4bf(wsr, v1, so, ga); bst4bf(wsr, v1 + 32u, so, gb);
            if (cc >= 1024) {
                float sm = ((ga[0] + ga[1]) + (ga[2] + ga[3])) + ((gb[0] + gb[1]) + (gb[2] + gb[3]));
                float sq = ((ga[0] * ga[0] + ga[1] * ga[1]) + (ga[2] * ga[2] + ga[3] * ga[3])) + ((gb[0] * gb[0] + gb[1] * gb[1]) + (gb[2] * gb[2] + gb[3] * gb[3]));
                sm += __shfl_xor(sm, 16); sq += __shfl_xor(sq, 16); sm += __shfl_xor(sm, 32); sq += __shfl_xor(sq, 32);
                u32x2 w; w.x = __float_as_uint(sm); w.y = __float_as_uint(sq);
                __builtin_amdgcn_raw_buffer_store_b64(w, wsr, fq == 0 ? (unsigned)(fr * 256) : 0xC0000000u, (unsigned)WS_PART + (unsigned)ru * 256u + (unsigned)((cc - 1024) >> 5) * 8u, 0);
            } }
        else { const unsigned v3 = (unsigned)(fr * (3 * D * 2) + fq * 8), so = (unsigned)WS_G + (unsigned)ru * (unsigned)(3 * D * 2) + (unsigned)(cu - 7168) * 2u; bst4bf(wsr, v3, so, sig4(va)); bst4bf(wsr, v3 + 32u, so, sig4(vb)); }
    }
    __device__ __forceinline__ void epi(f32x4 (&acc)[2][2][4][2], const Unit& u, int wr, int wc, int fr, int fq) const { pg8::run_epi<1>(*this, acc, u, wr, wc, fr, fq); }
};
struct ProbBranch {
    static constexpr bool GATHER = false, CHAIN = true;
    const unsigned char* ws; int K; pg8::StaticOrder S; rsrc_t wsr;
    __device__ __forceinline__ bool chain(const Unit& u) const { return u.e < 2; }
    __device__ __forceinline__ bool next(int i, Unit& u) const { int pm, pn; if (!S.next(i / 3, pm, pn)) return false; u.pm = pm; u.pn = pn; u.e = i % 3; u.it = 0; u.ne = 0; return true; }
    __device__ __forceinline__ const char* abase(const Unit& u) const { return (const char*)ws + WS_BA + (size_t)u.e * (WS_CB - WS_BA) + (size_t)u.pm * TSTEP_D; }
    __device__ __forceinline__ const char* bbase(const Unit& u) const { return (const char*)ws + WS_WA + (size_t)u.e * (WS_WB - WS_WA) + (size_t)u.pn * TSTEP_D; }
    __device__ __forceinline__ void goffs(const Unit&, const int (&)[2], const int (&)[2], unsigned (&)[2][2]) const {}
    struct Regs { u32x2 ga, gb, na, nb; };
    __device__ __forceinline__ void pre(const Unit& u, int ru, int cu, int fr, int fq, Regs& R) const {
        const unsigned v3 = (unsigned)(fr * (3 * D * 2) + fq * 8), sg = (unsigned)WS_G + (unsigned)ru * (unsigned)(3 * D * 2) + (unsigned)(u.e * D + cu) * 2u;
        R.ga = __builtin_amdgcn_raw_buffer_load_b64(wsr, v3, sg, 0); R.gb = __builtin_amdgcn_raw_buffer_load_b64(wsr, v3 + 32u, sg, 0);
        if (u.e < 2) { R.na = __builtin_amdgcn_raw_buffer_load_b64(wsr, v3, sg + (unsigned)(D * 2), 0); R.nb = __builtin_amdgcn_raw_buffer_load_b64(wsr, v3 + 32u, sg + (unsigned)(D * 2), 0); }
    }
    __device__ __forceinline__ void post(const Unit& u, int ru, int cu, int fr, int fq, const Regs& R, f32x4& va, f32x4& vb) const {
        const f32x4 ga = {bf_lo(R.ga.x), bf_hi(R.ga.x), bf_lo(R.ga.y), bf_hi(R.ga.y)}, gb = {bf_lo(R.gb.x), bf_hi(R.gb.x), bf_lo(R.gb.y), bf_hi(R.gb.y)};
        if (u.e < 2) {
            const f32x4 na = {bf_lo(R.na.x), bf_hi(R.na.x), bf_lo(R.na.y), bf_hi(R.na.y)}, nb = {bf_lo(R.nb.x), bf_hi(R.nb.x), bf_lo(R.nb.y), bf_hi(R.nb.y)};
#pragma unroll
            for (int j = 0; j < 4; ++j) { va[j] = va[j] * ga[j] * __builtin_amdgcn_rcpf(fmaxf(na[j], 1e-30f)); vb[j] = vb[j] * gb[j] * __builtin_amdgcn_rcpf(fmaxf(nb[j], 1e-30f)); }
        } else {
            const unsigned v1 = (unsigned)(fr * (D * 2) + fq * 8), so = (unsigned)WS_H + (unsigned)ru * (unsigned)(D * 2) + (unsigned)cu * 2u;
            bst4bf(wsr, v1, so, va * ga); bst4bf(wsr, v1 + 32u, so, vb * gb);
        }
    }
    __device__ __forceinline__ void epi(f32x4 (&acc)[2][2][4][2], const Unit& u, int wr, int wc, int fr, int fq) const { pg8::run_epi<2>(*this, acc, u, wr, wc, fr, fq); }
};
struct ProbWo {
    static constexpr bool GATHER = false, CHAIN = false; __device__ __forceinline__ bool chain(const Unit&) const { return false; }
    const bf16_t* A; const bf16_t* Bt; int K; pg8::StaticOrder S;
    rsrc_t xin, xout;
    __device__ __forceinline__ bool next(int i, Unit& u) const { int pm, pn; if (!S.next(i, pm, pn)) return false; u.pm = pm; u.pn = pn; u.e = 0; u.it = 0; u.ne = 0; return true; }
    __device__ __forceinline__ const char* abase(const Unit& u) const { return (const char*)A + (size_t)u.pm * TSTEP_D; }
    __device__ __forceinline__ const char* bbase(const Unit& u) const { return (const char*)Bt + (size_t)u.pn * TSTEP_D; }
    __device__ __forceinline__ void goffs(const Unit&, const int (&)[2], const int (&)[2], unsigned (&)[2][2]) const {}
    struct Regs { f32x4 xa, xb; };
    __device__ __forceinline__ void pre(const Unit&, int ru, int cu, int fr, int fq, Regs& R) const {
        const unsigned v = (unsigned)(fr * (D * 4) + fq * 16), so = (unsigned)ru * (unsigned)(D * 4) + (unsigned)cu * 4u;
        R.xa = bld4f(xin, v, so); R.xb = bld4f(xin, v + 64u, so);
    }
    __device__ __forceinline__ void post(const Unit&, int ru, int cu, int fr, int fq, const Regs& R, f32x4 va, f32x4 vb) const {
        const unsigned v = (unsigned)(fr * (D * 4) + fq * 16), so = (unsigned)ru * (unsigned)(D * 4) + (unsigned)cu * 4u;
        bst4f(xout, v, so, R.xa + va); bst4f(xout, v + 64u, so, R.xb + vb);
    }
    __device__ __forceinline__ void epi(f32x4 (&acc)[2][2][4][2], const Unit& u, int wr, int wc, int fr, int fq) const { pg8::run_epi<2>(*this, acc, u, wr, wc, fr, fq); }
};
constexpr int MOE_TAB_MAX = 192;
__device__ __forceinline__ void moe_build_table(const unsigned* cnt, LAS int* cntL, LAS int* tab, LAS int* ntl, int tid) {
    if (tid < NE) cntL[tid] = (int)ld_agent(cnt + tid);
    __syncthreads();
    if (tid == 0) { int acc = 0; for (int e = 0; e < NE; ++e) { const int nt = (cntL[e] + 255) >> 8; for (int it = 0; it < nt; ++it) tab[acc + it] = (e << 8) | it; acc += nt; } ntl[0] = acc; }
    __syncthreads();
}
__device__ __forceinline__ bool moe_next(int i, int G, int c, int ntiles, const LAS int* tab, const LAS int* cntL, Unit& u) {
    const int L = i * G + c; if (L >= 4 * ntiles) return false;
    const int ti = L >> 2, ent = __builtin_amdgcn_readfirstlane(tab[ti]);
    u.pm = ti; u.pn = L & 3; u.e = ent >> 8; u.it = ent & 255; u.ne = __builtin_amdgcn_readfirstlane(cntL[ent >> 8]); return true;
}
struct ProbMoe1 {
    static constexpr bool GATHER = true, CHAIN = false; __device__ __forceinline__ bool chain(const Unit&) const { return false; }
    const bf16_t* H2; const bf16_t* W13; int K; int G, c;
    const LAS int* cntL; const LAS int* tab; int ntiles;
    rsrc_t wsr;
    __device__ __forceinline__ bool next(int i, Unit& u) const { return moe_next(i, G, c, ntiles, tab, cntL, u); }
    __device__ __forceinline__ const char* abase(const Unit&) const { return (const char*)H2; }
    __device__ __forceinline__ const char* bbase(const Unit& u) const { return (const char*)W13 + ((size_t)u.e * 1024 + (size_t)u.pn * 256) * D * 2; }
    __device__ __forceinline__ void goffs(const Unit& u, const int (&R)[2], const int (&C)[2], unsigned (&o)[2][2]) const {
#pragma unroll
        for (int h = 0; h < 2; ++h)
#pragma unroll
            for (int i = 0; i < 2; ++i) {
                const int idx = u.it * 256 + h * 128 + R[i];
                const int tok = (int)__builtin_amdgcn_raw_buffer_load_b32(wsr, (unsigned)(R[i] * 4), (unsigned)WS_STOK + (unsigned)(u.e * CAP + u.it * 256 + h * 128) * 4u, 0);
                o[h][i] = (unsigned)((idx < u.ne ? tok : T) * D + C[i]) * 2u;
            }
    }
    struct Regs { unsigned rs; };
    __device__ __forceinline__ void pre(const Unit& u, int ru, int, int fr, int, Regs& R) const {
        R.rs = __builtin_amdgcn_raw_buffer_load_b32(wsr, (unsigned)(fr * 4), (unsigned)WS_SRS + (unsigned)(u.e * CAP + u.it * 256 + (ru - u.pm * 256)) * 4u, 0);
    }
    __device__ __forceinline__ void post(const Unit& u, int ru, int cu, int fr, int fq, const Regs& R, f32x4 va, f32x4 vb) const {
        const float rs = (u.it * 256 + (ru - u.pm * 256) + fr) < u.ne ? __uint_as_float(R.rs) : 0.f;
        bst4bf(wsr, (unsigned)(fr * (DFF * 2) + fq * 8), (unsigned)WS_ACT + (unsigned)ru * (unsigned)(DFF * 2) + (unsigned)pcu(cu) * 2u, silu4(va * rs) * (vb * rs));
    }
    __device__ __forceinline__ void epi(f32x4 (&acc)[2][2][4][2], const Unit& u, int wr, int wc, int fr, int fq) const { pg8::run_epi<4>(*this, acc, u, wr, wc, fr, fq); }
};
struct ProbMoe2 {
    static constexpr bool GATHER = false, CHAIN = false; __device__ __forceinline__ bool chain(const Unit&) const { return false; }
    const bf16_t* ACT; const bf16_t* W2; int K; int G, c;
    const LAS int* cntL; const LAS int* tab; int ntiles;
    rsrc_t wsr;
    __device__ __forceinline__ bool next(int i, Unit& u) const { return moe_next(i, G, c, ntiles, tab, cntL, u); }
    __device__ __forceinline__ const char* abase(const Unit& u) const { return (const char*)ACT + (size_t)u.pm * 256 * DFF * 2; }
    __device__ __forceinline__ const char* bbase(const Unit& u) const { return (const char*)W2 + ((size_t)u.e * 1024 + (size_t)u.pn * 256) * DFF * 2; }
    __device__ __forceinline__ void goffs(const Unit&, const int (&)[2], const int (&)[2], unsigned (&)[2][2]) const {}
    struct Regs { unsigned w, asg; };
    __device__ __forceinline__ void pre(const Unit& u, int ru, int, int fr, int, Regs& R) const {
        const unsigned ss = (unsigned)(u.e * CAP + u.it * 256 + (ru - u.pm * 256)) * 4u;
        R.w = __builtin_amdgcn_raw_buffer_load_b32(wsr, (unsigned)(fr * 4), (unsigned)WS_SW + ss, 0); R.asg = __builtin_amdgcn_raw_buffer_load_b32(wsr, (unsigned)(fr * 4), (unsigned)WS_SASG + ss, 0);
    }
    __device__ __forceinline__ void post(const Unit& u, int ru, int cu, int fr, int fq, const Regs& R, f32x4 va, f32x4 vb) const {
        const int idx = u.it * 256 + (ru - u.pm * 256) + fr;
        const float w = __uint_as_float(R.w);
        const unsigned v = idx < u.ne ? R.asg * (unsigned)(D * 2) + (unsigned)(fq * 8) : 0xC0000000u;
        const unsigned so = (unsigned)WS_YC + (unsigned)cu * 2u;
        bst4bf(wsr, v, so, va * w); bst4bf(wsr, v + 32u, so, vb * w);
    }
    __device__ __forceinline__ void epi(f32x4 (&acc)[2][2][4][2], const Unit& u, int wr, int wc, int fr, int fq) const { pg8::run_epi<4>(*this, acc, u, wr, wc, fr, fq); }
};

#define XB_TMO      128
#define XB_XCNT(j)  (256  + 64 * (j))
#define XB_XSUB(j)  (1280 + 64 * (j))
#define XB_XGEN(j)  (2304 + 64 * (j))
#define XB_TOP      3328
#define XB_TOPGEN   3392
#define XCD_BAR_WORDS 3456
#define XB_SPIN_CAP (1u << 18)
__device__ __forceinline__ unsigned xb_ld(unsigned* p)              { return __hip_atomic_load(p, __ATOMIC_RELAXED, __HIP_MEMORY_SCOPE_AGENT); }
__device__ __forceinline__ unsigned xb_add(unsigned* p, unsigned v) { return __hip_atomic_fetch_add(p, v, __ATOMIC_RELAXED, __HIP_MEMORY_SCOPE_AGENT); }
__device__ __forceinline__ unsigned xb_xcc_id() { return (unsigned)__builtin_amdgcn_s_getreg((3 << 11) | 20) & 0xFu; }
#define XB_SPIN(cond, bar) do { unsigned _sp = 0; while (cond) { __builtin_amdgcn_s_sleep(1); \
    if ((++_sp & 255u) == 0u) { if (xb_ld(&(bar)[XB_TMO])) break; if (_sp > XB_SPIN_CAP) { atomicAdd(&(bar)[XB_TMO], 1u); break; } } } } while (0)
struct XcdBarrier {
    unsigned* bar; unsigned x;
    volatile LAS unsigned* st;
};
__device__ __forceinline__ XcdBarrier xcd_barrier_post(unsigned* bar, volatile LAS unsigned* st) {
    XcdBarrier b; b.bar = bar; b.x = xb_xcc_id(); b.st = st;
    if (threadIdx.x == 0) (void)xb_add(&bar[XB_XCNT(b.x)], 1u);
    return b;
}
__device__ __forceinline__ void xcd_barrier_complete(unsigned* bar, unsigned x, unsigned& nloc, unsigned& nx) {
    const unsigned G = gridDim.x * gridDim.y * gridDim.z;
    unsigned sum, cnt, mine, sp = 0u;
    for (;;) {
        sum = 0u; cnt = 0u; mine = 0u;
#pragma unroll
        for (unsigned j = 0; j < 16; ++j) { const unsigned c = xb_ld(&bar[XB_XCNT(j)]); sum += c; cnt += (c > 0u) ? 1u : 0u; mine = (j == x) ? c : mine; }
        if (sum == G) break;
        __builtin_amdgcn_s_sleep(1);
        if ((++sp & 255u) == 0u) { if (xb_ld(&bar[XB_TMO])) break; if (sp > XB_SPIN_CAP) { atomicAdd(&bar[XB_TMO], 1u); break; } }
    }
    nloc = mine > 0u ? mine : 1u; nx = cnt > 0u ? cnt : 1u;
}
__device__ __forceinline__ void xcd_barrier(const XcdBarrier& b) {
    asm volatile("s_waitcnt vmcnt(0)" ::: "memory");
    __syncthreads();
    if (threadIdx.x == 0) {
        unsigned* bar = b.bar;
        __builtin_amdgcn_s_waitcnt(0);
        unsigned nloc = b.st[0], nx = b.st[1];
        if (nloc == 0u) { xcd_barrier_complete(bar, b.x, nloc, nx); b.st[0] = nloc; b.st[1] = nx; }
        const unsigned old = xb_add(&bar[XB_XSUB(b.x)], 1u);
        const unsigned gen = old / nloc;
        if (old + 1u == (gen + 1u) * nloc) {
            __builtin_amdgcn_fence(__ATOMIC_RELEASE, "agent");
            asm volatile("s_waitcnt vmcnt(0)" ::: "memory");
            const unsigned og = xb_add(&bar[XB_TOP], 1u);
            const unsigned tg = og / nx;
            if (og + 1u == (tg + 1u) * nx) xb_add(&bar[XB_TOPGEN], 1u);
            else XB_SPIN(xb_ld(&bar[XB_TOPGEN]) == tg, bar);
            __builtin_amdgcn_fence(__ATOMIC_ACQUIRE, "agent");
            xb_add(&bar[XB_XGEN(b.x)], 1u);
            asm volatile("s_waitcnt vmcnt(0)" ::: "memory");
        } else {
            XB_SPIN(xb_ld(&bar[XB_XGEN(b.x)]) == gen, bar);
            __builtin_amdgcn_fence(__ATOMIC_ACQUIRE, "agent");
            asm volatile("s_waitcnt vmcnt(0)" ::: "memory");
        }
    }
    __syncthreads();
}

static_assert(MOE_OFF + (32 + MOE_TAB_MAX + 4) * 4 <= RT_LOG && MID_LDS <= RING_BYTES && 256 * 65 * 4 <= RING_BYTES, "LDS map");
static_assert(WS_U - WS_CB == WS_CB - WS_BA && WS_WC - WS_WB == WS_WB - WS_WA, "branch operands equally spaced");
constexpr int NPH = 8 * NL + 1;

struct Args { const float* in[24]; float* out; unsigned char* ws; int ph_lo, ph_hi, bar_region, pad; CvtTable tb[NL]; };
#define WSA(type, off) ((type*)(a->ws + (off)))
#define KARGS() ({ const CAS Args* q_ = kp; asm volatile("" : "+s"(q_)); q_; })

#ifndef PROBE_MASK
#define PROBE_MASK 0
#endif
__global__ void __launch_bounds__(512, 2) mk_fwd(Args a_unused) {
    extern __shared__ __attribute__((aligned(16))) unsigned char lds_[];
    LAS unsigned char* lds = (LAS unsigned char*)lds_;
    volatile LAS unsigned* MISC = (volatile LAS unsigned*)(lds + MISC_OFF);
    for (int u = threadIdx.x; u < (LDS_BYTES - LDSCTL_OFF) / 4; u += 512) ((LAS unsigned*)(lds + LDSCTL_OFF))[u] = 0u;
    __syncthreads();
    const CAS Args* kp = (const CAS Args*)__builtin_amdgcn_kernarg_segment_ptr();
    int lo, hi; XcdBarrier bar;
    { const CAS Args* a = KARGS(); lo = a->ph_lo; hi = a->ph_hi; bar = xcd_barrier_post(WSA(unsigned, WS_CTL) + CW_BAR + a->bar_region * XCD_BAR_WORDS, MISC + 8); }
#ifndef PHMASK
#define PHMASK 0x1ff
#endif
#define IN(k) (((PHMASK >> (((k) == 8 * NL) ? 8 : ((k) & 7))) & 1) && lo <= (k) && (k) < hi)
#define PHASE_REGS() int tid = threadIdx.x; asm volatile("" : "+v"(tid)); int bid = blockIdx.x, G = gridDim.x; asm volatile("" : "+s"(bid), "+s"(G))
#define SEAM(k) do { if ((k) + 1 < hi) xcd_barrier(bar); } while (0)
    LAS int* cntL = (LAS int*)(lds + MOE_OFF); LAS int* tabL = cntL + 32; LAS int* ntl = tabL + MOE_TAB_MAX;
    unsigned long long probe_t = 0ull, probe_t0 = 0ull; (void)probe_t0;
#define PB(j) do { if ((PROBE_MASK >> (j)) & 1) probe_t0 = __builtin_amdgcn_s_memrealtime(); } while (0)
#define PE(j) do { if ((PROBE_MASK >> (j)) & 1) probe_t += __builtin_amdgcn_s_memrealtime() - probe_t0; } while (0)

    for (int l = 0; l < NL; ++l) {
        const int k0 = 8 * l;
        if (IN(k0 + 0)) { PB(0);
            PHASE_REGS(); const CAS Args* a = KARGS(); bf16_t* const Hb = WSA(bf16_t, WS_H); unsigned* const ctl = WSA(unsigned, WS_CTL); (void)ctl; (void)Hb;
            if (l == 0) cvt_phase(&a->tb[0], 0, NCVT, G, 0, (LAS float*)lds, tid, bid, G);
            if (l == 0 && bid < 4) { unsigned* z = WSA(unsigned, WS_ZB) + (size_t)((bid >> 1) * ZSEQ + (bid & 1) * (SEQ + ZPAD)) * (D / 2); for (int i = tid; i < ZPAD * D / 2; i += 512) z[i] = 0u; }
            { const int row = bid * 8 + (tid >> 6); if (row < NHC * 128) { const float* wp = a->in[11] + ((size_t)l * NHC * 128 + row) * 128 + (tid & 63); const float sm = wave_sum(wp[0] + wp[64]); if ((tid & 63) == 0) WSA(float, WS_STAT)[row] = sm; } }
            if (l == 0) norm_phase<false, false>(a->in[0], nullptr, nullptr, a->in[1], Hb, nullptr, tid, bid, G);
            else norm_phase<true, false>(a->out, a->out, WSA(bf16_t, WS_YC), a->in[1] + l * D, Hb, nullptr, tid, bid, G);
            SEAM(k0 + 0); PE(0);
        }
        if (IN(k0 + 1)) { PB(1);
            PHASE_REGS(); const CAS Args* a = KARGS(); bf16_t* const Hb = WSA(bf16_t, WS_H); unsigned* const ctl = WSA(unsigned, WS_CTL); (void)ctl; (void)Hb;
            ProbInProj P; P.A = Hb; P.Bt = WSA(bf16_t, WS_WIN); P.K = D; P.S.init(T, DIN, G, bid);
            P.wsr = mkrsrc(a->ws, (unsigned)WS_END);
            pg8::gemm_phase<ProbInProj, true>(lds, P, tid);
            SEAM(k0 + 1); PE(1);
        }
        if (IN(k0 + 2)) { PB(2);
            PHASE_REGS(); const CAS Args* a = KARGS(); bf16_t* const Hb = WSA(bf16_t, WS_H); unsigned* const ctl = WSA(unsigned, WS_CTL); (void)ctl; (void)Hb;
            mid_phase(mkrsrc(a->ws, (unsigned)WS_END), a->ws, WSA(bf16_t, WS_V),
                      a->in[3] + (size_t)l * 3 * D, a->in[5] + (size_t)l * 31 * D, a->in[6] + l * D, a->in[7] + l * D, a->in[9] + l * D, a->in[10] + l * D,
                      a->in[11] + (size_t)l * NHC * 128 * 128, a->in[12] + l * NHC * 128, WSA(float, WS_STAT), lds, tid, bid, G, probe_t);
            SEAM(k0 + 2); PE(2);
        }
        if (IN(k0 + 3)) { PB(3);
            PHASE_REGS(); const CAS Args* a = KARGS(); bf16_t* const Hb = WSA(bf16_t, WS_H); unsigned* const ctl = WSA(unsigned, WS_CTL); (void)ctl; (void)Hb;
            ProbBranch P; P.ws = a->ws;
            P.K = D; P.S.init(T, D, G, bid); P.wsr = mkrsrc(a->ws, (unsigned)WS_END);
            pg8::gemm_phase<ProbBranch, true>(lds, P, tid);
            SEAM(k0 + 3); PE(3);
        }
        if (IN(k0 + 4)) { PB(4);
            PHASE_REGS(); const CAS Args* a = KARGS(); bf16_t* const Hb = WSA(bf16_t, WS_H); unsigned* const ctl = WSA(unsigned, WS_CTL); (void)ctl; (void)Hb;
            ProbWo P; P.A = Hb; P.Bt = WSA(bf16_t, WS_WO); P.K = D; P.S.init(T, D, G, bid); P.xin = mkrsrc((l == 0) ? a->in[0] : a->out, (unsigned)((size_t)T * D * 4)); P.xout = mkrsrc(a->out, (unsigned)((size_t)T * D * 4));
            pg8::gemm_phase<ProbWo, false>(lds, P, tid);
            SEAM(k0 + 4); PE(4);
        }
        if (IN(k0 + 5)) { PB(5);
            PHASE_REGS(); const CAS Args* a = KARGS(); bf16_t* const Hb = WSA(bf16_t, WS_H); unsigned* const ctl = WSA(unsigned, WS_CTL); (void)ctl; (void)Hb;
            router_phase(mkrsrc(a->out, (unsigned)((size_t)T * D * 4)), mkrsrc(a->in[15] + l * D, D * 4), mkrsrc(a->in[16] + (size_t)l * D * NG, D * NG * 4), mkrsrc(a->ws, (unsigned)WS_END), a->in[17] + l * NG, a->in[18] + (size_t)l * D * NE, a->in[19] + l * NE,
                         Hb, ctl + CW_CNT + 64 * l, WSA(int, WS_STOK), WSA(float, WS_SW), WSA(int, WS_SASG), WSA(float, WS_SRS), lds, tid, bid, G);
            SEAM(k0 + 5); PE(5);
        }
        if (IN(k0 + 6)) { PB(6);
            PHASE_REGS(); const CAS Args* a = KARGS(); bf16_t* const Hb = WSA(bf16_t, WS_H); unsigned* const ctl = WSA(unsigned, WS_CTL); (void)ctl; (void)Hb;
            moe_build_table(ctl + CW_CNT + 64 * l, cntL, tabL, ntl, tid);
            ProbMoe1 P; P.H2 = Hb; P.W13 = WSA(bf16_t, WS_W13); P.K = D; P.G = G; P.c = bid; P.cntL = cntL; P.tab = tabL; P.ntiles = __builtin_amdgcn_readfirstlane(ntl[0]); P.wsr = mkrsrc(a->ws, (unsigned)WS_END);
            pg8::gemm_phase<ProbMoe1, true>(lds, P, tid);
            if (l + 1 < NL) { const int rem = (4 * P.ntiles) % G; cvt_phase(&a->tb[l + 1], 0, NCVT - 1, rem == 0 ? G : rem, 8, (LAS float*)lds, tid, bid, G); }
            SEAM(k0 + 6); PE(6);
        }
        if (IN(k0 + 7)) { PB(7);
            PHASE_REGS(); const CAS Args* a = KARGS(); bf16_t* const Hb = WSA(bf16_t, WS_H); unsigned* const ctl = WSA(unsigned, WS_CTL); (void)ctl; (void)Hb;
            moe_build_table(ctl + CW_CNT + 64 * l, cntL, tabL, ntl, tid);
            ProbMoe2 P; P.ACT = WSA(bf16_t, WS_ACT); P.W2 = (l & 1) ? WSA(bf16_t, WS_W2B) : WSA(bf16_t, WS_W2); P.K = DFF; P.G = G; P.c = bid; P.cntL = cntL; P.tab = tabL; P.ntiles = __builtin_amdgcn_readfirstlane(ntl[0]); P.wsr = mkrsrc(a->ws, (unsigned)WS_END);
            pg8::gemm_phase<ProbMoe2, true>(lds, P, tid);
            if (l + 1 < NL) { const int rem = (4 * P.ntiles) % G; cvt_phase(&a->tb[l + 1], NCVT - 1, NCVT, rem == 0 ? G : rem, 4, (LAS float*)lds, tid, bid, G); }
            SEAM(k0 + 7); PE(7);
        }
    }
    if (IN(8 * NL)) { PHASE_REGS(); const CAS Args* a = KARGS(); norm_phase<true, true>(a->out, nullptr, WSA(bf16_t, WS_YC), a->in[23], nullptr, a->out, tid, bid, G); }
    if ((PROBE_MASK != 0 || PROBE_MID != 0) && blockIdx.x == 0) { const unsigned long long t = __builtin_amdgcn_s_memrealtime(); while (__builtin_amdgcn_s_memrealtime() - t < probe_t) __builtin_amdgcn_s_sleep(8); }
#undef IN
#undef SEAM
}

static void build_cvt(CvtTable& tb, void* const* d_in, unsigned char* ws, int l) {
    const float* w_in = (const float*)d_in[2] + (size_t)l * D * DIN;
    auto set = [&](int i, const float* A, const float* B, bf16_t* dst, int ld, int K, int ndst, int pair, int cA, int cB, int batch, long sb, long db) {
        CvtDesc& c = tb.d[i]; c.A = A; c.B = B; c.dst = dst; c.ld = ld; c.K = K; c.ndst = ndst; c.pair = pair; c.colA0 = cA; c.colB0 = cB; c.batch = batch; c.sbatch = sb; c.dbatch = db;
        c.items = batch * (ndst / 64) * (K / 256); };
    bf16_t* win = (bf16_t*)(ws + WS_WIN);
    set(0, w_in, w_in, win, DIN, D, 2048, 1, 0, 2048, 1, 0, 0);
    set(1, w_in, nullptr, win + (size_t)2048 * D, DIN, D, 1024, 0, 1024, 0, 1, 0, 0);
    set(2, w_in, w_in, win + (size_t)3072 * D, DIN, D, 2048, 1, 3072, 4096, 1, 0, 0);
    set(3, w_in, nullptr, win + (size_t)5120 * D, DIN, D, 2048, 0, 5120, 0, 1, 0, 0);
    set(4, w_in, nullptr, win + (size_t)7168 * D, DIN, D, 3072, 0, 7168, 0, 1, 0, 0);
    set(5, (const float*)d_in[4] + (size_t)l * D * D, nullptr, (bf16_t*)(ws + WS_WA), D, D, D, 0, 0, 0, 1, 0, 0);
    set(6, (const float*)d_in[8] + (size_t)l * D * D, nullptr, (bf16_t*)(ws + WS_WB), D, D, D, 0, 0, 0, 1, 0, 0);
    set(7, (const float*)d_in[13] + (size_t)l * D * D, nullptr, (bf16_t*)(ws + WS_WC), D, D, D, 0, 0, 0, 1, 0, 0);
    set(8, (const float*)d_in[14] + (size_t)l * D * D, nullptr, (bf16_t*)(ws + WS_WO), D, D, D, 0, 0, 0, 1, 0, 0);
    set(9, (const float*)d_in[22] + (size_t)l * NE * DFF * D, nullptr, (bf16_t*)(ws + ((l & 1) ? WS_W2B : WS_W2)), D, DFF, D, 0, 0, 0, NE, (long)DFF * D, (long)D * DFF);
    set(10, (const float*)d_in[20] + (size_t)l * NE * D * DFF, (const float*)d_in[21] + (size_t)l * NE * D * DFF, (bf16_t*)(ws + WS_W13), DFF, D, 1024, 1, 0, 0, NE, (long)D * DFF, (long)1024 * D);
    tb.total = 0; for (int i = 0; i < NCVT; ++i) tb.total += tb.d[i].items; tb.pad = 0;
}

#ifndef MK_CUTS
#define MK_CUTS 0
#endif

extern "C" void kernel_launch(void* const* d_in, const int* in_sizes, int n_in, void* d_out, int out_size, void* d_ws, size_t ws_size, hipStream_t stream) {
    static int grid = 0;
    if (grid == 0) {
        if (n_in != 24 || ws_size < WS_END) { fprintf(stderr, "kernel_launch: unexpected n_in %d or ws_size %zu < %zu\n", n_in, ws_size, (size_t)WS_END); grid = -1; return; }
        int dev = 0, cus = 0, per_cu = 0;
        if (hipGetDevice(&dev) != hipSuccess || hipDeviceGetAttribute(&cus, hipDeviceAttributeMultiprocessorCount, dev) != hipSuccess) { grid = -1; return; }
        if (hipFuncSetAttribute((const void*)mk_fwd, hipFuncAttributeMaxDynamicSharedMemorySize, LDS_BYTES) != hipSuccess) { fprintf(stderr, "kernel_launch: hipFuncSetAttribute failed\n"); grid = -1; return; }
        if (hipOccupancyMaxActiveBlocksPerMultiprocessor(&per_cu, (const void*)mk_fwd, 512, LDS_BYTES) != hipSuccess || per_cu < 1) { fprintf(stderr, "kernel_launch: occupancy query says %d\n", per_cu); }
        (void)hipGetLastError();
        grid = cus;
    }
    if (grid < 0) return;
    unsigned char* ws = (unsigned char*)d_ws;
    (void)hipMemsetAsync(ws + WS_CTL, 0, CTL_BYTES, stream);
    Args a{};
    for (int i = 0; i < 24; ++i) a.in[i] = (const float*)d_in[i];
    a.out = (float*)d_out; a.ws = ws;
    for (int l = 0; l < NL; ++l) build_cvt(a.tb[l], d_in, ws, l);
#if MK_CUTS == 0
    a.ph_lo = 0; a.ph_hi = NPH; a.bar_region = 0;
    hipLaunchKernelGGL(mk_fwd, dim3(grid), dim3(512), LDS_BYTES, stream, a);
#elif MK_CUTS == 1
    for (int k = 0; k < NPH; ++k) { a.ph_lo = k; a.ph_hi = k + 1; a.bar_region = 0; hipLaunchKernelGGL(mk_fwd, dim3(grid), dim3(512), LDS_BYTES, stream, a); }
#else
    a.ph_lo = 0; a.ph_hi = 8; a.bar_region = 0; hipLaunchKernelGGL(mk_fwd, dim3(grid), dim3(512), LDS_BYTES, stream, a);
    a.ph_lo = 8; a.ph_hi = NPH; a.bar_region = 1; hipLaunchKernelGGL(mk_fwd, dim3(grid), dim3(512), LDS_BYTES, stream, a);
#endif
}
```

```cpp
#include <hip/hip_runtime.h>
#include <stdint.h>
#include <stdio.h>

#define LAS __attribute__((address_space(3)))
#define CAS __attribute__((address_space(4)))
typedef unsigned short bf16_t;
typedef short bf16x8 __attribute__((ext_vector_type(8)));
typedef float f32x4 __attribute__((ext_vector_type(4)));
typedef float f32x2 __attribute__((ext_vector_type(2)));
typedef unsigned u32x4 __attribute__((ext_vector_type(4)));
typedef unsigned u32x2 __attribute__((ext_vector_type(2)));

constexpr int T = 16384, D = 1024, SEQ = 8192, DIN = 10240, NE = 32, NG = 4, EPG = 8, DFF = 512, NHC = 8;
constexpr int CAP = 16384;
constexpr int NL = 2;
constexpr float RMS_EPS = 1e-6f, LN_EPS = 1e-5f;

constexpr size_t MiB = 1u << 20;
constexpr size_t WS_CTL = 0, CTL_BYTES = 32768;
constexpr size_t WS_WIN = 2 * MiB, WS_WA = 22 * MiB, WS_WB = 24 * MiB, WS_WC = 26 * MiB, WS_WO = 28 * MiB, WS_W13 = 30 * MiB, WS_W2 = 94 * MiB;
constexpr size_t WS_H = 126 * MiB;
constexpr size_t WS_QA = 159 * MiB, WS_BA = 191 * MiB, WS_U = 255 * MiB, WS_V = 287 * MiB, WS_G = 319 * MiB;
constexpr size_t WS_W2B = 415 * MiB;
constexpr size_t WS_ZB = 447 * MiB;
constexpr int ZPAD = 15, ZSEQ = SEQ + 2 * ZPAD;
constexpr size_t WS_CB = 223 * MiB;
constexpr size_t WS_DELTA = WS_QA;
constexpr size_t WS_ACT = WS_QA;
constexpr size_t WS_YC = 223 * MiB;
constexpr size_t WS_STOK = 511 * MiB, WS_SW = 513 * MiB, WS_SASG = 515 * MiB;
constexpr size_t WS_STAT = 517 * MiB;
constexpr size_t WS_PART = 485 * MiB;
constexpr size_t WS_SRS = 481 * MiB;
constexpr size_t WS_END = 518 * MiB;
constexpr int CW_CNT = 0;
constexpr int CW_BAR = 1024;

typedef __bf16 bf16x2_t __attribute__((ext_vector_type(2)));
__device__ __forceinline__ unsigned cvt_pk_bf16(float lo, float hi) { bf16x2_t v; v.x = (__bf16)lo; v.y = (__bf16)hi; return __builtin_bit_cast(unsigned, v); }
__device__ __forceinline__ float bf_lo(unsigned p) { return __uint_as_float(p << 16); }
__device__ __forceinline__ float bf_hi(unsigned p) { return __uint_as_float(p & 0xffff0000u); }
__device__ __forceinline__ float wave_sum(float v) {
#pragma unroll
    for (int o = 1; o < 64; o <<= 1) v += __shfl_xor(v, o);
    return v;
}
__device__ __forceinline__ float sigmoidf_(float x) { return __builtin_amdgcn_rcpf(1.0f + __expf(-x)); }
__device__ __forceinline__ float siluf_(float x) { return x * sigmoidf_(x); }
__device__ __forceinline__ float gelu_tanh_(float x) { const float z = 0.7978845608028654f * (x + 0.044715f * x * x * x); return x * sigmoidf_(2.0f * z); }
__device__ __forceinline__ f32x4 sig4(f32x4 v) { return (f32x4){sigmoidf_(v[0]), sigmoidf_(v[1]), sigmoidf_(v[2]), sigmoidf_(v[3])}; }
__device__ __forceinline__ f32x4 silu4(f32x4 v) { return (f32x4){siluf_(v[0]), siluf_(v[1]), siluf_(v[2]), siluf_(v[3])}; }
__device__ __forceinline__ f32x4 gelu4(f32x4 v) { return (f32x4){gelu_tanh_(v[0]), gelu_tanh_(v[1]), gelu_tanh_(v[2]), gelu_tanh_(v[3])}; }
__device__ __forceinline__ void store4bf(bf16_t* p, f32x4 v) { u32x2 w; w.x = cvt_pk_bf16(v[0], v[1]); w.y = cvt_pk_bf16(v[2], v[3]); *(u32x2*)p = w; }
__device__ __forceinline__ f32x4 load4bf(const bf16_t* p) { const u32x2 w = *(const u32x2*)p; return (f32x4){bf_lo(w.x), bf_hi(w.x), bf_lo(w.y), bf_hi(w.y)}; }
__device__ __forceinline__ unsigned ld_agent(const unsigned* p) { return __hip_atomic_load(p, __ATOMIC_RELAXED, __HIP_MEMORY_SCOPE_AGENT); }

typedef __amdgpu_buffer_rsrc_t rsrc_t;
__device__ __forceinline__ rsrc_t mkrsrc(const void* p, unsigned bytes) { return __builtin_amdgcn_make_buffer_rsrc(const_cast<void*>(p), (short)0, (int)bytes, 0x00020000); }
__device__ __forceinline__ f32x4 bld4bf(rsrc_t r, unsigned voff, unsigned soff) { const u32x2 w = __builtin_amdgcn_raw_buffer_load_b64(r, voff, soff, 0); return (f32x4){bf_lo(w.x), bf_hi(w.x), bf_lo(w.y), bf_hi(w.y)}; }
__device__ __forceinline__ void bst4bf(rsrc_t r, unsigned voff, unsigned soff, f32x4 v) { u32x2 w; w.x = cvt_pk_bf16(v[0], v[1]); w.y = cvt_pk_bf16(v[2], v[3]); __builtin_amdgcn_raw_buffer_store_b64(w, r, voff, soff, 0); }
__device__ __forceinline__ void bst8bf(rsrc_t r, unsigned voff, unsigned soff, f32x4 a, f32x4 b) { u32x4 w; w.x = cvt_pk_bf16(a[0], a[1]); w.y = cvt_pk_bf16(a[2], a[3]); w.z = cvt_pk_bf16(b[0], b[1]); w.w = cvt_pk_bf16(b[2], b[3]); __builtin_amdgcn_raw_buffer_store_b128(w, r, voff, soff, 0); }
__device__ __forceinline__ f32x4 bld4f(rsrc_t r, unsigned voff, unsigned soff) { const u32x4 w = __builtin_amdgcn_raw_buffer_load_b128(r, voff, soff, 0); return (f32x4){__uint_as_float(w.x), __uint_as_float(w.y), __uint_as_float(w.z), __uint_as_float(w.w)}; }
__device__ __forceinline__ void bst4f(rsrc_t r, unsigned voff, unsigned soff, f32x4 v) { u32x4 w; w.x = __float_as_uint(v[0]); w.y = __float_as_uint(v[1]); w.z = __float_as_uint(v[2]); w.w = __float_as_uint(v[3]); __builtin_amdgcn_raw_buffer_store_b128(w, r, voff, soff, 0); }
__device__ __forceinline__ int pair_col(int c) { return 32 * (c >> 6) + 16 * ((c >> 5) & 1) + (c & 15); }

struct CvtDesc { const float* A; const float* B; bf16_t* dst; long sbatch, dbatch; int ld, K, ndst, pair, colA0, colB0, batch, items; };
constexpr int NCVT = 11;
struct CvtTable { CvtDesc d[NCVT]; int total, pad; };

struct CvtItem { const float* A; const float* B; bf16_t* dst; int ld, K, pair, cA, cB, nb, k0; };
__device__ __forceinline__ void cvt_decode(const CAS CvtTable* tb, int dlo, int dhi, int it, CvtItem& x) {
    int r = it, di = dlo;
    while (di < dhi - 1 && r >= tb->d[di].items) { r -= tb->d[di].items; ++di; }
    const int K = tb->d[di].K, ntn = tb->d[di].ndst / 64, ntk = K / 256;
    const int b = r / (ntn * ntk), rem = r % (ntn * ntk);
    x.nb = rem / ntk; x.k0 = (rem % ntk) * 256; x.K = K; x.ld = tb->d[di].ld; x.pair = tb->d[di].pair; x.cA = tb->d[di].colA0; x.cB = tb->d[di].colB0;
    x.A = tb->d[di].A + (size_t)b * tb->d[di].sbatch; x.B = tb->d[di].B ? tb->d[di].B + (size_t)b * tb->d[di].sbatch : x.A; x.dst = tb->d[di].dst + (size_t)b * tb->d[di].dbatch;
}
__device__ __forceinline__ void cvt_load(const CvtItem& x, int tid, f32x4 (&R)[8]) {
#pragma unroll
    for (int i = 0; i < 8; ++i) {
        const int idx = tid + 512 * i, kk = idx >> 4, s16 = idx & 15;
        const float* src = (x.pair && (s16 >> 3)) ? x.B : x.A;
        const int col = x.pair ? ((s16 >> 3) ? x.cB : x.cA) + 32 * x.nb + 4 * (s16 & 7) : x.cA + 64 * x.nb + 4 * s16;
        R[i] = *(const f32x4*)(src + (size_t)(x.k0 + kk) * x.ld + col);
    }
}
__device__ __forceinline__ void cvt_phase(const CAS CvtTable* tb, int dlo, int dhi, int r, int credit, LAS float* tile, int tid, int bid, int nblk) {
    int total = 0; for (int d = dlo; d < dhi; ++d) total += tb->d[d].items;
    const int lane = tid & 63, wid = tid >> 6;
    int F = (nblk - r) * credit; F = F < total ? F : total;
    int nfront = 0; if (bid >= r) { nfront = F - (bid - r) * credit; nfront = nfront < 0 ? 0 : (nfront > credit ? credit : nfront); }
#define CVT_ITEM(j) ((j) < nfront ? (bid - r) * credit + (j) : F + ((j) - nfront) * nblk + bid)
    int j = 0, it = CVT_ITEM(0); if (it >= total) return;
    CvtItem cur, nxt; f32x4 R[8];
    cvt_decode(tb, dlo, dhi, it, cur); cvt_load(cur, tid, R);
    for (;;) {
#pragma unroll
        for (int i = 0; i < 8; ++i) {
            const int idx = tid + 512 * i, kk = idx >> 4, s16 = idx & 15;
#pragma unroll
            for (int e = 0; e < 4; ++e) {
                const int c32 = 4 * (s16 & 7) + e;
                const int l = 4 * s16 + e;
                const int nl = cur.pair ? (((c32 >> 4) * 2 + (s16 >> 3)) * 16 + (c32 & 15)) : ((l & ~31) + 16 * ((l >> 2) & 1) + 4 * ((l & 31) >> 3) + (l & 3));
                tile[kk * 65 + nl] = R[i][e];
            }
        }
        __syncthreads();
        const int itn = CVT_ITEM(j + 1); const bool more = itn < total;
        if (more) { cvt_decode(tb, dlo, dhi, itn, nxt); cvt_load(nxt, tid, R); }
#pragma unroll
        for (int i = 0; i < 4; ++i) {
            const int task = wid * 4 + i, nl = (task & 7) * 8 + (lane >> 3), ch = (task >> 3) * 8 + (lane & 7);
            const LAS float* sp = tile + (8 * ch) * 65 + nl;
            u32x4 o; o.x = cvt_pk_bf16(sp[0], sp[65]); o.y = cvt_pk_bf16(sp[2 * 65], sp[3 * 65]); o.z = cvt_pk_bf16(sp[4 * 65], sp[5 * 65]); o.w = cvt_pk_bf16(sp[6 * 65], sp[7 * 65]);
            *(u32x4*)(cur.dst + (size_t)(cur.nb * 64 + nl) * cur.K + cur.k0 + 8 * ch) = o;
        }
        __syncthreads();
        if (!more) break;
        ++j; it = itn; cur = nxt;
    }
#undef CVT_ITEM
}

template <bool COMBINE, bool FINAL>
__device__ __forceinline__ void norm_phase(const float* xsrc, float* xbuf, const bf16_t* yc, const float* g, bf16_t* h, float* outf, int tid, int bid, int nblk) {
    const int lane = tid & 63, wave = tid >> 6, nw = 8;
    f32x4 gv[4];
#pragma unroll
    for (int j = 0; j < 4; ++j) gv[j] = *(const f32x4*)(g + 4 * lane + 256 * j);
    for (int row = bid * nw + wave; row < T; row += nblk * nw) {
        f32x4 v[4]; float ss = 0.f;
#pragma unroll
        for (int j = 0; j < 4; ++j) {
            v[j] = *(const f32x4*)(xsrc + (size_t)row * D + 4 * lane + 256 * j);
            if (COMBINE) { v[j] += load4bf(yc + (size_t)(2 * row) * D + 4 * lane + 256 * j); v[j] += load4bf(yc + (size_t)(2 * row + 1) * D + 4 * lane + 256 * j); }
            ss += (v[j][0] * v[j][0] + v[j][1] * v[j][1]) + (v[j][2] * v[j][2] + v[j][3] * v[j][3]);
        }
        const float rstd = rsqrtf(wave_sum(ss) * (1.0f / D) + RMS_EPS);
#pragma unroll
        for (int j = 0; j < 4; ++j) {
            if (COMBINE && !FINAL) *(f32x4*)(xbuf + (size_t)row * D + 4 * lane + 256 * j) = v[j];
            const f32x4 o = v[j] * rstd * gv[j];
            if (FINAL) *(f32x4*)(outf + (size_t)row * D + 4 * lane + 256 * j) = o;
            else store4bf(h + (size_t)row * D + 4 * lane + 256 * j, o);
        }
    }
}

constexpr int RING_BYTES = 131072;
constexpr int LDSCTL_OFF = RING_BYTES, MISC_OFF = LDSCTL_OFF + 320;
constexpr int MOE_OFF = LDSCTL_OFF + 1024;
constexpr int RT_LOG = LDSCTL_OFF + 2048;
constexpr int RT_HIST = RT_LOG + 64 * 40 * 4;
constexpr int LDS_BYTES = 147456;
static_assert(RT_HIST + 256 <= LDS_BYTES, "LDS map");
__device__ __forceinline__ void router_phase(rsrc_t xr, rsrc_t xo, rsrc_t gr, rsrc_t wgr, rsrc_t wsr, const float* bg, const float* wr, const float* br,
                                             bf16_t* h2, unsigned* cnt, int* slot_tok, float* slot_w, int* slot_asg, float* slot_rs, LAS unsigned char* lds, int tid, int bid, int nblk) {
    const int lane = tid & 63, wid = __builtin_amdgcn_readfirstlane(tid >> 6), kk = lane & 15, rg = lane >> 4;
    if (bid == 0) for (int i = tid; i < D / 2; i += 512) ((unsigned*)(h2 + (size_t)T * D))[i] = 0u;
    for (int idx = tid; idx < 8192; idx += 512) {
        const int k = idx >> 3, q = idx & 7, kk_ = (k & 63) >> 2, e = k & 3, c = k >> 6;
        *(LAS f32x4*)(lds + q * 16384 + c * 1024 + e * 256 + kk_ * 16) = *(const f32x4*)(wr + (size_t)k * NE + 4 * q);
    }
    LAS float* logit = (LAS float*)(lds + RT_LOG); LAS int* hist = (LAS int*)(lds + RT_HIST); LAS int* base = hist + 32;
    __syncthreads();
    for (int rb = bid; rb < T / 64; rb += nblk) {
        const int rl0 = wid * 8 + rg;
        const unsigned vx = (unsigned)(rg * (D * 4) + kk * 16), vh = (unsigned)(rg * (D * 2) + kk * 8), vg = (unsigned)(kk * 16), vw = (unsigned)(kk * 64);
        const unsigned sx0 = (unsigned)(rb * 64 + wid * 8) * (unsigned)(D * 4), sx1 = sx0 + (unsigned)(4 * D * 4);
        const unsigned sh0 = (unsigned)WS_H + (unsigned)(rb * 64 + wid * 8) * (unsigned)(D * 2), sh1 = sh0 + (unsigned)(4 * D * 2);
        const unsigned sd0 = (unsigned)WS_DELTA + (unsigned)(rb * 64 + wid * 8) * (unsigned)(D * 2), sd1 = sd0 + (unsigned)(4 * D * 2);
        float a0[36], a1[36];
#pragma unroll
        for (int i = 0; i < 36; ++i) { a0[i] = 0.f; a1[i] = 0.f; }
        float ss0 = 0.f, ss1 = 0.f;
        f32x4 rxa[3], rxb[3]; u32x2 rda[3], rdb[3];
#pragma unroll
        for (int j = 0; j < 3; ++j) { rxa[j] = bld4f(xr, vx, sx0 + (unsigned)(256 * j)); rxb[j] = bld4f(xr, vx, sx1 + (unsigned)(256 * j));
            rda[j] = __builtin_amdgcn_raw_buffer_load_b64(wsr, vh, sd0 + (unsigned)(128 * j), 0); rdb[j] = __builtin_amdgcn_raw_buffer_load_b64(wsr, vh, sd1 + (unsigned)(128 * j), 0); }
        f32x4 ngg = bld4f(gr, vg, 0u);
#pragma unroll 1
        for (int c4 = 0; c4 < 18; c4 += 3) {
#pragma unroll
            for (int j = 0; j < 3; ++j) {
                const int c = c4 + j; if (c >= 16) break;
                f32x4 xa = rxa[j] + (f32x4){bf_lo(rda[j].x), bf_hi(rda[j].x), bf_lo(rda[j].y), bf_hi(rda[j].y)}, xb = rxb[j] + (f32x4){bf_lo(rdb[j].x), bf_hi(rdb[j].x), bf_lo(rdb[j].y), bf_hi(rdb[j].y)};
                const f32x4 gg = ngg; f32x4 wgv[4];
#pragma unroll
                for (int e = 0; e < 4; ++e) wgv[e] = bld4f(wgr, vw + (unsigned)(16 * e), (unsigned)(c * 1024));
                const int cx = c + 3 < 16 ? c + 3 : c, cn = c + 1 < 16 ? c + 1 : c;
                rxa[j] = bld4f(xr, vx, sx0 + (unsigned)(256 * cx)); rxb[j] = bld4f(xr, vx, sx1 + (unsigned)(256 * cx));
                rda[j] = __builtin_amdgcn_raw_buffer_load_b64(wsr, vh, sd0 + (unsigned)(128 * cx), 0); rdb[j] = __builtin_amdgcn_raw_buffer_load_b64(wsr, vh, sd1 + (unsigned)(128 * cx), 0);
                bst4f(xo, vx, sx0 + (unsigned)(256 * c), xa); bst4f(xo, vx, sx1 + (unsigned)(256 * c), xb);
                ngg = bld4f(gr, vg, (unsigned)(256 * cn));
                ss0 += (xa[0] * xa[0] + xa[1] * xa[1]) + (xa[2] * xa[2] + xa[3] * xa[3]);
                ss1 += (xb[0] * xb[0] + xb[1] * xb[1]) + (xb[2] * xb[2] + xb[3] * xb[3]);
                xa *= gg; xb *= gg;
                bst4bf(wsr, vh, sh0 + (unsigned)(128 * c), xa); bst4bf(wsr, vh, sh1 + (unsigned)(128 * c), xb);
                const LAS unsigned char* wl = lds + c * 1024 + kk * 16;
#pragma unroll
                for (int e = 0; e < 4; ++e) {
#pragma unroll
                    for (int i = 0; i < 4; ++i) { a0[i] += xa[e] * wgv[e][i]; a1[i] += xb[e] * wgv[e][i]; }
#pragma unroll
                    for (int q = 0; q < 8; ++q) { const f32x4 wv = *(const LAS f32x4*)(wl + q * 16384 + e * 256);
#pragma unroll
                        for (int i = 0; i < 4; ++i) { a0[4 + 4 * q + i] += xa[e] * wv[i]; a1[4 + 4 * q + i] += xb[e] * wv[i]; } }
                    asm volatile("" ::: "memory");
                }
            }
        }
#pragma unroll
        for (int o = 1; o < 16; o <<= 1) {
            ss0 += __shfl_xor(ss0, o); ss1 += __shfl_xor(ss1, o);
#pragma unroll
            for (int i = 0; i < 36; ++i) { a0[i] += __shfl_xor(a0[i], o); a1[i] += __shfl_xor(a1[i], o); }
        }
        const float rstd0 = rsqrtf(ss0 * (1.0f / D) + RMS_EPS), rstd1 = rsqrtf(ss1 * (1.0f / D) + RMS_EPS);
        if (kk == 0) {
#pragma unroll
            for (int i = 0; i < 36; ++i) { const float b = i < 4 ? bg[i] : br[i - 4]; logit[rl0 * 40 + i] = a0[i] * rstd0 + b; logit[(rl0 + 4) * 40 + i] = a1[i] * rstd1 + b; }
            logit[rl0 * 40 + 36] = rstd0; logit[(rl0 + 4) * 40 + 36] = rstd1;
        }
        if (tid < 32) hist[tid] = 0;
        asm volatile("s_waitcnt lgkmcnt(0)" ::: "memory"); __syncthreads();
        int e0 = 0, e1 = 0, lr0 = 0, lr1 = 0; float w0 = 0.f, w1 = 0.f;
        if (tid < 64) {
            const LAS float* lp = logit + tid * 40;
            int gi = 0; float gm = lp[0];
#pragma unroll
            for (int i = 1; i < NG; ++i) { const float v = lp[i]; if (v > gm) { gm = v; gi = i; } }
            float gs = 0.f;
#pragma unroll
            for (int i = 0; i < NG; ++i) gs += __expf(lp[i] - gm);
            const float gp = 1.0f / gs;
            const LAS float* ep = lp + 4 + gi * EPG;
            int i0 = 0; float m0 = ep[0];
#pragma unroll
            for (int i = 1; i < EPG; ++i) { const float v = ep[i]; if (v > m0) { m0 = v; i0 = i; } }
            int i1 = -1; float m1 = -3.0e38f;
#pragma unroll
            for (int i = 0; i < EPG; ++i) { const float v = ep[i]; if (i != i0 && v > m1) { m1 = v; i1 = i; } }
            const float ex = __expf(m1 - m0); w0 = gp / (1.0f + ex); w1 = gp * ex / (1.0f + ex);
            e0 = gi * EPG + i0; e1 = gi * EPG + i1;
            lr0 = __hip_atomic_fetch_add((int*)(hist + e0), 1, __ATOMIC_RELAXED, __HIP_MEMORY_SCOPE_WORKGROUP);
            lr1 = __hip_atomic_fetch_add((int*)(hist + e1), 1, __ATOMIC_RELAXED, __HIP_MEMORY_SCOPE_WORKGROUP);
        }
        asm volatile("s_waitcnt lgkmcnt(0)" ::: "memory"); __syncthreads();
        if (tid < 32) { const int n = hist[tid]; base[tid] = n > 0 ? (int)atomicAdd(cnt + tid, (unsigned)n) : 0; }
        asm volatile("s_waitcnt vmcnt(0) lgkmcnt(0)" ::: "memory"); __syncthreads();
        if (tid < 64) {
            const int row = rb * 64 + tid, s0 = e0 * CAP + base[e0] + lr0, s1 = e1 * CAP + base[e1] + lr1;
            const float rs = logit[tid * 40 + 36];
            slot_tok[s0] = row; slot_w[s0] = w0; slot_asg[s0] = 2 * row; slot_rs[s0] = rs;
            slot_tok[s1] = row; slot_w[s1] = w1; slot_asg[s1] = 2 * row + 1; slot_rs[s1] = rs;
        }
        __syncthreads();
    }
}

__device__ __forceinline__ void midA_phase(const bf16_t* QA, bf16_t* BA, const float* cw  , int bid, int nblk) {
    const int nthr = blockDim.x;
    for (int idx = bid * nthr + threadIdx.x; idx < T * (D / 8); idx += nblk * nthr) {
        const int t = idx >> 7, c = (idx & 127) * 8, s = t & (SEQ - 1);
        const u32x4 z = {0u, 0u, 0u, 0u};
        const u32x4 q1 = *(const u32x4*)(QA + (size_t)t * D + c);
        u32x4 q0 = *(const u32x4*)(QA + (size_t)(s > 0 ? t - 1 : t) * D + c);
        u32x4 q2 = *(const u32x4*)(QA + (size_t)(s < SEQ - 1 ? t + 1 : t) * D + c);
        q0 = s > 0 ? q0 : z; q2 = s < SEQ - 1 ? q2 : z;
        const u32x4 bb = *(const u32x4*)(BA + (size_t)t * D + c);
        u32x4 o;
#pragma unroll
        for (int j = 0; j < 4; ++j) {
            const int c0 = c + 2 * j;
            const float lo = bf_lo(bb[j]) * (cw[c0] * bf_lo(q0[j]) + cw[D + c0] * bf_lo(q1[j]) + cw[2 * D + c0] * bf_lo(q2[j]));
            const float hi = bf_hi(bb[j]) * (cw[c0 + 1] * bf_hi(q0[j]) + cw[D + c0 + 1] * bf_hi(q1[j]) + cw[2 * D + c0 + 1] * bf_hi(q2[j]));
            o[j] = cvt_pk_bf16(lo, hi);
        }
        *(u32x4*)(BA + (size_t)t * D + c) = o;
    }
}
__device__ __forceinline__ void midB_conv_phase(const bf16_t* ZB, bf16_t* CB, const float* cw  , int bid, int nblk) {
    for (int cp = threadIdx.x; cp < D / 2; cp += blockDim.x) {
        f32x2 w[31];
#pragma unroll
        for (int j = 0; j < 31; ++j) w[j] = *(const f32x2*)(cw + j * D + 2 * cp);
        for (int tg = bid; tg < T / 16; tg += nblk) {
            const int t0 = tg * 16, s0 = t0 & (SEQ - 1);
            f32x2 acc[16];
#pragma unroll
            for (int o = 0; o < 16; ++o) acc[o] = (f32x2){0.f, 0.f};
#pragma unroll
            for (int i = 0; i < 46; ++i) {
                const int s = s0 - 15 + i;
                const bool ok = (s >= 0 && s < SEQ);
                unsigned xv = *(const unsigned*)(ZB + (size_t)(ok ? t0 - 15 + i : t0) * D + 2 * cp);
                xv = ok ? xv : 0u;
                const f32x2 x = {bf_lo(xv), bf_hi(xv)};
#pragma unroll
                for (int o = 0; o < 16; ++o) { const int j = i - o; if (j >= 0 && j < 31) acc[o] += w[j] * x; }
            }
#pragma unroll
            for (int o = 0; o < 16; ++o) *(unsigned*)(CB + (size_t)(t0 + o) * D + 2 * cp) = cvt_pk_bf16(acc[o][0], acc[o][1]);
        }
    }
}
__device__ __forceinline__ void row16_load(const bf16_t* rowp, int lane, float (&x)[16]) {
    const u32x4 a = *(const u32x4*)(rowp + 8 * lane), b = *(const u32x4*)(rowp + 512 + 8 * lane);
#pragma unroll
    for (int j = 0; j < 4; ++j) { x[2 * j] = bf_lo(a[j]); x[2 * j + 1] = bf_hi(a[j]); x[8 + 2 * j] = bf_lo(b[j]); x[8 + 2 * j + 1] = bf_hi(b[j]); }
}
__device__ __forceinline__ void row16_stats(const float (&x)[16], float& mean, float& rstd) {
    float s = 0.f;
#pragma unroll
    for (int j = 0; j < 16; ++j) s += x[j];
    mean = wave_sum(s) * (1.0f / D);
    float q = 0.f;
#pragma unroll
    for (int j = 0; j < 16; ++j) { const float d = x[j] - mean; q += d * d; }
    rstd = rsqrtf(wave_sum(q) * (1.0f / D) + LN_EPS);
}
__device__ __forceinline__ void midB_ln_phase(bf16_t* CB, const float* g, const float* b, int bid, int nblk) {
    const int lane = threadIdx.x & 63, wave = threadIdx.x >> 6, nw = blockDim.x >> 6;
    float gg[16], bb[16];
#pragma unroll
    for (int j = 0; j < 8; ++j) { gg[j] = g[8 * lane + j]; gg[8 + j] = g[512 + 8 * lane + j]; bb[j] = b[8 * lane + j]; bb[8 + j] = b[512 + 8 * lane + j]; }
    for (int row = bid * nw + wave; row < T; row += nblk * nw) {
        float x[16], mean, rstd; row16_load(CB + (size_t)row * D, lane, x); row16_stats(x, mean, rstd);
        u32x4 o0, o1;
#pragma unroll
        for (int j = 0; j < 4; ++j) {
            o0[j] = cvt_pk_bf16(siluf_((x[2 * j] - mean) * rstd * gg[2 * j] + bb[2 * j]), siluf_((x[2 * j + 1] - mean) * rstd * gg[2 * j + 1] + bb[2 * j + 1]));
            o1[j] = cvt_pk_bf16(siluf_((x[8 + 2 * j] - mean) * rstd * gg[8 + 2 * j] + bb[8 + 2 * j]), siluf_((x[8 + 2 * j + 1] - mean) * rstd * gg[8 + 2 * j + 1] + bb[8 + 2 * j + 1]));
        }
        *(u32x4*)(CB + (size_t)row * D + 8 * lane) = o0; *(u32x4*)(CB + (size_t)row * D + 512 + 8 * lane) = o1;
    }
}
__device__ __forceinline__ void midC_stats_phase(const bf16_t* V, float* stat, int bid, int nblk) {
    const int lane = threadIdx.x & 63, wave = threadIdx.x >> 6, nw = blockDim.x >> 6;
    for (int row = bid * nw + wave; row < T; row += nblk * nw) {
        float x[16], mean, rstd; row16_load(V + (size_t)row * D, lane, x); row16_stats(x, mean, rstd);
        if (lane == 0) *(f32x2*)(stat + 2 * row) = (f32x2){mean, rstd};
    }
}
#ifndef PROBE_MID
#define PROBE_MID 0
#endif
constexpr int MC_LD = 272;
constexpr int MID_SA = 0, MID_SB = 64 * MC_LD, MID_LDS = MID_SB + 128 * MC_LD;
constexpr int MID_STAT = 131072 + 2048;
__device__ __forceinline__ void mid_phase(rsrc_t wsr, unsigned char* wsb, const bf16_t* V,
                                          const float* cwa  , const float* cwb  , const float* lnbg, const float* lnbb, const float* lncg, const float* lncb,
                                          const float* Ws  , const float* bs  , const float* rowsum  , LAS unsigned char* lds, int tid, int bid, int nblk, unsigned long long& mpt) {
    const int lane = tid & 63, wid = __builtin_amdgcn_readfirstlane(tid >> 6), fr = lane & 15, fq = lane >> 4;
    unsigned long long mp0 = 0ull; (void)mp0;
#define MPB(j) do { if ((PROBE_MID >> (j)) & 1) { __syncthreads(); mp0 = __builtin_amdgcn_s_memrealtime(); } } while (0)
#define MPE(j) do { if ((PROBE_MID >> (j)) & 1) { asm volatile("s_waitcnt vmcnt(0) lgkmcnt(0)" ::: "memory"); __syncthreads(); mpt += __builtin_amdgcn_s_memrealtime() - mp0; } } while (0)
    LAS float* statL = (LAS float*)(lds + MID_STAT); LAS unsigned char* SA = lds + MID_SA; LAS unsigned char* SB = lds + MID_SB;
    const u32x4 z4 = {0u, 0u, 0u, 0u};
    for (int tile = bid; tile < T / 64; tile += nblk) {
        const int t0 = tile * 64, ch0 = (tile >> 1) * 128, half = tile & 1;
        const bf16_t* QA = (const bf16_t*)(wsb + WS_QA); bf16_t* BA = (bf16_t*)(wsb + WS_BA);
        MPB(0);
        {
            int tz = tid; asm volatile("" : "+v"(tz));
            const int c = (tz & 127) * 8, r0 = tz >> 7;
            float w0[8], w1[8], w2[8];
#pragma unroll
            for (int j = 0; j < 8; ++j) { w0[j] = cwa[c + j]; w1[j] = cwa[D + c + j]; w2[j] = cwa[2 * D + c + j]; }
#pragma unroll 1
            for (int k4 = 0; k4 < 16; k4 += 4) {
                u32x4 q0[4], q1[4], q2[4], bb[4];
#pragma unroll
                for (int u = 0; u < 4; ++u) {
                    const int t = t0 + r0 + 4 * (k4 + u), sq = t & (SEQ - 1);
                    q1[u] = *(const u32x4*)(QA + (size_t)t * D + c);
                    q0[u] = *(const u32x4*)(QA + (size_t)(sq > 0 ? t - 1 : t) * D + c);
                    q2[u] = *(const u32x4*)(QA + (size_t)(sq < SEQ - 1 ? t + 1 : t) * D + c);
                    bb[u] = *(const u32x4*)(BA + (size_t)t * D + c);
                }
#pragma unroll
                for (int u = 0; u < 4; ++u) {
                    const int t = t0 + r0 + 4 * (k4 + u), sq = t & (SEQ - 1);
                    const u32x4 a0 = sq > 0 ? q0[u] : z4, a2 = sq < SEQ - 1 ? q2[u] : z4;
                    u32x4 o;
#pragma unroll
                    for (int e = 0; e < 4; ++e) {
                        const float lo = bf_lo(bb[u][e]) * (w0[2 * e] * bf_lo(a0[e]) + w1[2 * e] * bf_lo(q1[u][e]) + w2[2 * e] * bf_lo(a2[e]));
                        const float hi = bf_hi(bb[u][e]) * (w0[2 * e + 1] * bf_hi(a0[e]) + w1[2 * e + 1] * bf_hi(q1[u][e]) + w2[2 * e + 1] * bf_hi(a2[e]));
                        o[e] = cvt_pk_bf16(lo, hi);
                    }
                    *(u32x4*)(BA + (size_t)t * D + c) = o;
                }
            }
        }
        MPE(0); MPB(1);
        {
            int cp = tid; asm volatile("" : "+v"(cp) :: "memory");
            f32x2 w[31];
#pragma unroll
            for (int j = 0; j < 31; ++j) w[j] = *(const f32x2*)(cwb + j * D + 2 * cp);
            const unsigned zrow0 = (unsigned)(t0 + 2 * ZPAD * (t0 >= SEQ ? 1 : 0));
#pragma unroll 1
            for (int g = 0; g < 2; ++g) {
                const unsigned sb = (unsigned)WS_ZB + (zrow0 + 32u * (unsigned)g) * (unsigned)(D * 2);
                f32x2 acc[32];
#pragma unroll
                for (int o = 0; o < 32; ++o) acc[o] = (f32x2){0.f, 0.f};
#pragma unroll
                for (int ib = 0; ib < 62; ib += 31) {
                    unsigned xv[31];
#pragma unroll
                    for (int q = 0; q < 31; ++q) xv[q] = __builtin_amdgcn_raw_buffer_load_b32(wsr, (unsigned)(4 * cp), sb + (unsigned)((ib + q) * D * 2), 0);
#pragma unroll
                    for (int q = 0; q < 31; ++q) {
                        const int i = ib + q; const f32x2 x = {bf_lo(xv[q]), bf_hi(xv[q])};
#pragma unroll
                        for (int o = 0; o < 32; ++o) { const int j = i - o; if (j >= 0 && j < 31) acc[o] += w[j] * x; }
                    }
                }
#pragma unroll
                for (int o = 0; o < 32; ++o) *(LAS unsigned*)(lds + (32 * g + o) * (D * 2) + 4 * cp) = cvt_pk_bf16(acc[o][0], acc[o][1]);
            }
        }
        MPE(1); MPB(2);
        if (tid < 128) {
            const unsigned so = (unsigned)WS_PART + (unsigned)ch0 * 256u;
            u32x4 pp[16];
#pragma unroll
            for (int j = 0; j < 16; ++j) pp[j] = __builtin_amdgcn_raw_buffer_load_b128(wsr, (unsigned)(tid * 256 + j * 16), so, 0);
            float sm = 0.f, sq = 0.f;
#pragma unroll
            for (int j = 0; j < 16; ++j) { sm += __uint_as_float(pp[j].x); sq += __uint_as_float(pp[j].y); sm += __uint_as_float(pp[j].z); sq += __uint_as_float(pp[j].w); }
            const float mean = sm * (1.0f / D), var = sq * (1.0f / D) - mean * mean;
            statL[2 * tid] = mean; statL[2 * tid + 1] = rsqrtf(fmaxf(var, 0.f) + LN_EPS);
        }
        asm volatile("s_waitcnt vmcnt(0) lgkmcnt(0)" ::: "memory"); __syncthreads();
        {
            int ld_ = lane; asm volatile("" : "+v"(ld_));
            float gg[16], bb[16];
#pragma unroll
            for (int j = 0; j < 8; ++j) { gg[j] = lnbg[8 * ld_ + j]; gg[8 + j] = lnbg[512 + 8 * ld_ + j]; bb[j] = lnbb[8 * ld_ + j]; bb[8 + j] = lnbb[512 + 8 * ld_ + j]; }
#pragma unroll 1
            for (int rq = 0; rq < 8; rq += 4) {
                float x[4][16];
#pragma unroll
                for (int j = 0; j < 4; ++j) { const u32x4 a = *(const LAS u32x4*)(lds + (wid * 8 + rq + j) * (D * 2) + lane * 16), b = *(const LAS u32x4*)(lds + (wid * 8 + rq + j) * (D * 2) + 1024 + lane * 16);
#pragma unroll
                    for (int e = 0; e < 4; ++e) { x[j][2 * e] = bf_lo(a[e]); x[j][2 * e + 1] = bf_hi(a[e]); x[j][8 + 2 * e] = bf_lo(b[e]); x[j][8 + 2 * e + 1] = bf_hi(b[e]); } }
#pragma unroll
                for (int j = 0; j < 4; ++j) {
                    float mean, rstd; row16_stats(x[j], mean, rstd);
                    u32x4 o0, o1;
#pragma unroll
                    for (int e = 0; e < 4; ++e) {
                        o0[e] = cvt_pk_bf16(siluf_((x[j][2 * e] - mean) * rstd * gg[2 * e] + bb[2 * e]), siluf_((x[j][2 * e + 1] - mean) * rstd * gg[2 * e + 1] + bb[2 * e + 1]));
                        o1[e] = cvt_pk_bf16(siluf_((x[j][8 + 2 * e] - mean) * rstd * gg[8 + 2 * e] + bb[8 + 2 * e]), siluf_((x[j][8 + 2 * e + 1] - mean) * rstd * gg[8 + 2 * e + 1] + bb[8 + 2 * e + 1]));
                    }
                    const unsigned so = (unsigned)WS_CB + (unsigned)(t0 + wid * 8 + rq + j) * (unsigned)(D * 2);
                    __builtin_amdgcn_raw_buffer_store_b128(o0, wsr, (unsigned)(lane * 16), so, 0); __builtin_amdgcn_raw_buffer_store_b128(o1, wsr, (unsigned)(lane * 16 + 1024), so, 0);
                }
            }
        }
        asm volatile("s_waitcnt lgkmcnt(0)" ::: "memory"); __syncthreads();
        MPE(2); MPB(3);
        {
            const int wr = wid >> 2, wc = wid & 3;
            int te = tid; asm volatile("" : "+v"(te));
            f32x4 ra[2][2][2]; u32x4 rv[2][2][2]; u32x2 ru[2][2][2]; f32x4 rg[2][2], rbe[2][2]; float rs[2][2], rbi[2][2];
#define MID_ISSUE(h, S) do { \
_Pragma("unroll") \
                for (int i = 0; i < 2; ++i) { const int idx = te + 512 * i, pr = idx >> 4, q8 = idx & 15; const float* sp = Ws + ((size_t)(h) * 128 + half * 64 + pr) * 128 + q8 * 8; ra[S][i][0] = *(const f32x4*)sp; ra[S][i][1] = *(const f32x4*)(sp + 4); } \
_Pragma("unroll") \
                for (int i = 0; i < 2; ++i) { const int idx = te + 512 * i, qp = idx & 63, c8 = idx >> 6; const bf16_t* vp = V + (size_t)(ch0 + 2 * qp) * D + (h) * 128 + c8 * 8; rv[S][i][0] = *(const u32x4*)vp; rv[S][i][1] = *(const u32x4*)(vp + D); } \
_Pragma("unroll") \
                for (int m = 0; m < 2; ++m) { rs[S][m] = rowsum[(h) * 128 + half * 64 + wr * 32 + m * 16 + fr]; rbi[S][m] = bs[(h) * 128 + half * 64 + wr * 32 + m * 16 + fr]; \
_Pragma("unroll") \
                    for (int nn = 0; nn < 2; ++nn) ru[S][m][nn] = __builtin_amdgcn_raw_buffer_load_b64(wsr, (unsigned)(fr * (D * 2) + fq * 8), (unsigned)WS_U + (unsigned)(t0 + wr * 32 + m * 16) * (unsigned)(D * 2) + (unsigned)((h) * 128 + wc * 32 + nn * 16) * 2u, 0); } \
_Pragma("unroll") \
                for (int nn = 0; nn < 2; ++nn) { rg[S][nn] = *(const f32x4*)(lncg + (h) * 128 + wc * 32 + nn * 16 + 4 * fq); rbe[S][nn] = *(const f32x4*)(lncb + (h) * 128 + wc * 32 + nn * 16 + 4 * fq); } \
             } while (0)
#define MID_HEAD(h, S) do { \
_Pragma("unroll") \
                for (int i = 0; i < 2; ++i) { const int idx = te + 512 * i, pr = idx >> 4, q8 = idx & 15; \
                    u32x4 o; o.x = cvt_pk_bf16(ra[S][i][0][0], ra[S][i][0][1]); o.y = cvt_pk_bf16(ra[S][i][0][2], ra[S][i][0][3]); o.z = cvt_pk_bf16(ra[S][i][1][0], ra[S][i][1][1]); o.w = cvt_pk_bf16(ra[S][i][1][2], ra[S][i][1][3]); \
                    *(LAS u32x4*)(SA + pr * MC_LD + q8 * 16) = o; } \
_Pragma("unroll") \
                for (int i = 0; i < 2; ++i) { const int idx = te + 512 * i, qp = idx & 63, c8 = idx >> 6; \
                    const f32x4 st = *(const LAS f32x4*)(statL + 4 * qp); \
_Pragma("unroll") \
                    for (int j = 0; j < 4; ++j) { \
                        *(LAS unsigned*)(SB + (c8 * 8 + 2 * j) * MC_LD + qp * 4) = cvt_pk_bf16((bf_lo(rv[S][i][0][j]) - st[0]) * st[1], (bf_lo(rv[S][i][1][j]) - st[2]) * st[3]); \
                        *(LAS unsigned*)(SB + (c8 * 8 + 2 * j + 1) * MC_LD + qp * 4) = cvt_pk_bf16((bf_hi(rv[S][i][0][j]) - st[0]) * st[1], (bf_hi(rv[S][i][1][j]) - st[2]) * st[3]); \
                    } } \
                u32x2 uc[2][2]; f32x4 gc[2], bc[2]; float sc[2], bic[2]; \
_Pragma("unroll") \
                for (int m = 0; m < 2; ++m) { sc[m] = rs[S][m]; bic[m] = rbi[S][m]; gc[m] = rg[S][m]; bc[m] = rbe[S][m]; \
_Pragma("unroll") \
                    for (int nn = 0; nn < 2; ++nn) uc[m][nn] = ru[S][m][nn]; } \
                asm volatile("s_waitcnt lgkmcnt(0)" ::: "memory"); __syncthreads(); \
                if ((h) + 2 < NHC) MID_ISSUE((h) + 2, S); \
                f32x4 acc[2][2]; \
_Pragma("unroll") \
                for (int m = 0; m < 2; ++m) \
_Pragma("unroll") \
                    for (int nn = 0; nn < 2; ++nn) acc[m][nn] = (f32x4){0.f, 0.f, 0.f, 0.f}; \
_Pragma("unroll") \
                for (int ks = 0; ks < 4; ++ks) { \
                    bf16x8 a[2], b[2]; \
_Pragma("unroll") \
                    for (int m = 0; m < 2; ++m) a[m] = *(const LAS bf16x8*)(SA + (wr * 32 + m * 16 + fr) * MC_LD + ks * 64 + fq * 16); \
_Pragma("unroll") \
                    for (int nn = 0; nn < 2; ++nn) b[nn] = *(const LAS bf16x8*)(SB + (wc * 32 + nn * 16 + fr) * MC_LD + ks * 64 + fq * 16); \
_Pragma("unroll") \
                    for (int m = 0; m < 2; ++m) \
_Pragma("unroll") \
                        for (int nn = 0; nn < 2; ++nn) acc[m][nn] = __builtin_amdgcn_mfma_f32_16x16x32_bf16(b[nn], a[m], acc[m][nn], 0, 0, 0); \
                } \
_Pragma("unroll") \
                for (int m = 0; m < 2; ++m) \
_Pragma("unroll") \
                    for (int nn = 0; nn < 2; ++nn) { \
                        const f32x4 uu = {bf_lo(uc[m][nn].x), bf_hi(uc[m][nn].x), bf_lo(uc[m][nn].y), bf_hi(uc[m][nn].y)}; \
                        const f32x4 o = gc[nn] * acc[m][nn] + (bc[nn] * sc[m] + bic[m]); \
                        bst4bf(wsr, (unsigned)(fr * (D * 2) + fq * 8), (unsigned)WS_U + (unsigned)(t0 + wr * 32 + m * 16) * (unsigned)(D * 2) + (unsigned)((h) * 128 + wc * 32 + nn * 16) * 2u, uu * o); \
                    } \
                asm volatile("s_waitcnt lgkmcnt(0)" ::: "memory"); __syncthreads(); \
             } while (0)
            MID_ISSUE(0, 0); MID_ISSUE(1, 1);
#pragma unroll 1
            for (int h = 0; h < NHC; h += 2) { MID_HEAD(h, 0); MID_HEAD(h + 1, 1); }
#undef MID_ISSUE
#undef MID_HEAD
        }
        MPE(3);
    }
}

namespace pg8 {
constexpr int BM = 256, BK = 64, HALF = 128, HTB = HALF * BK * 2  , STAGE_BYTES = 8 * HTB, NXCD = 8, WGM = 8;
__device__ __forceinline__ int lds_byte(int r, int c) { const int st = (r >> 4) * 2 + (c >> 5), rr = r & 15, cc = c & 31, ob = rr * 64 + cc * 2; return st * 1024 + (ob ^ (((ob >> 9) & 1) << 5)); }
__device__ __forceinline__ void stage_rc(int b, int& R, int& C) { const int st = b / 1024, sb = b % 1024, swz = sb ^ (((sb >> 9) & 1) << 5); R = (st >> 1) * 16 + swz / 64; C = (st & 1) * 32 + (swz % 64) / 2; }
struct Unit { int pm, pn, e, it, ne; };
struct StaticOrder {
    int nM, nN, nwg, G, c;
    __device__ __forceinline__ void init(int M, int N, int G_, int c_) { nM = M / BM; nN = N / BM; nwg = nM * nN; G = G_; c = c_; }
    __device__ __forceinline__ bool next(int i, int& pm, int& pn) const {
        const long L = (long)i * G + c; if (L >= nwg) return false;
        int wgid = (int)L; { const int q = nwg / NXCD, r = nwg % NXCD, xcd = wgid % NXCD, off = wgid / NXCD; wgid = (xcd < r ? xcd * (q + 1) : r * (q + 1) + (xcd - r) * q) + off; }
        const int nig = WGM * nN, gid = wgid / nig, fm = gid * WGM, gsz = (nM - fm) < WGM ? (nM - fm) : WGM;
        pm = fm + ((wgid % nig) % gsz); pn = (wgid % nig) / gsz; return true;
    }
};
template <int NGRP, class Epi> __device__ __forceinline__ void run_epi(const Epi& E, f32x4 (&acc)[2][2][4][2], const Unit& u, int wr, int wc, int fr, int fq) {
#pragma unroll
    for (int ai = 0; ai < 2; ++ai)
#pragma unroll
        for (int mb = 0; mb < 4; mb += NGRP) {
            typename Epi::Regs R[NGRP][2];
#pragma unroll
            for (int g = 0; g < NGRP; ++g)
#pragma unroll
                for (int bj = 0; bj < 2; ++bj) E.pre(u, u.pm * BM + ai * HALF + wr * 64 + (mb + g) * 16, u.pn * BM + bj * HALF + wc * 32, fr, fq, R[g][bj]);
#pragma unroll
            for (int g = 0; g < NGRP; ++g)
#pragma unroll
                for (int bj = 0; bj < 2; ++bj) E.post(u, u.pm * BM + ai * HALF + wr * 64 + (mb + g) * 16, u.pn * BM + bj * HALF + wc * 32, fr, fq, R[g][bj], acc[ai][bj][mb + g][0], acc[ai][bj][mb + g][1]);
            asm volatile("" ::: "memory");
        }
}
template <class Prob, bool ALIGN_EPI>
__device__ __forceinline__ void gemm_phase(LAS unsigned char* lds, const Prob& P, int tid) {
    const int wid = __builtin_amdgcn_readfirstlane(tid >> 6), lane = tid & 63, wr = wid >> 2, wc = wid & 3, fr = lane & 15, fq = lane >> 4;
    const int K = P.K, nt = K / BK;
    unsigned voffA[2], voffB[2]; int sR[2], sC[2];
#pragma unroll
    for (int i = 0; i < 2; ++i) { stage_rc(tid * 16 + i * 8192, sR[i], sC[i]); voffA[i] = (unsigned)(sR[i] * K + sC[i]) * 2u; voffB[i] = voffA[i]; }
    const size_t kstep = (size_t)(BK * 2);
    const size_t hstep = (size_t)HALF * K * 2;
    const unsigned ldsw = (unsigned)wid * 1024u;
    const int aoff = lds_byte(wr * 64 + fr, fq * 8), boff = lds_byte(wc * 32 + fr, fq * 8);
#define PG8_SA(b, h) (((b) * 2 + (h)) * HTB)
#define PG8_SB(b, h) ((4 + (b) * 2 + (h)) * HTB)
#define PG8_STAGE(bufoff, gbase, voff) do { _Pragma("unroll") for (int _i = 0; _i < 2; ++_i) \
        __builtin_amdgcn_global_load_lds((const unsigned*)((const char*)(gbase) + (voff)[_i]), (LAS unsigned*)(lds + (bufoff) + ldsw + _i * 8192), 16, 0, 0); } while (0)
#define PG8_STAGE_A(bufoff, ptr, h, go) do { if constexpr (Prob::GATHER) PG8_STAGE(bufoff, ptr, (go)[h]); else PG8_STAGE(bufoff, (ptr) + (h) * hstep, voffA); } while (0)
#define PG8_LDA(dst, b, h) do { _Pragma("unroll") for (int m = 0; m < 4; ++m) _Pragma("unroll") for (int k = 0; k < 2; ++k) dst[m][k] = *(const LAS bf16x8*)(lds + PG8_SA(b, h) + aoff + m * 2048 + k * 1024); } while (0)
#define PG8_LDB(dst, b, h) do { _Pragma("unroll") for (int n = 0; n < 2; ++n) _Pragma("unroll") for (int k = 0; k < 2; ++k) dst[n][k] = *(const LAS bf16x8*)(lds + PG8_SB(b, h) + boff + n * 2048 + k * 1024); } while (0)
#define PG8_MMA(ai, bj, At, Bt) do { __builtin_amdgcn_s_setprio(1); _Pragma("unroll") for (int m = 0; m < 4; ++m) _Pragma("unroll") for (int n = 0; n < 2; ++n) _Pragma("unroll") for (int k = 0; k < 2; ++k) \
        acc[ai][bj][m][n] = __builtin_amdgcn_mfma_f32_16x16x32_bf16(Bt[n][k], At[m][k], acc[ai][bj][m][n], 0, 0, 0); __builtin_amdgcn_s_setprio(0); } while (0)
#define PG8_WAIT_V(n) asm volatile("s_waitcnt vmcnt(" #n ")" ::: "memory")
#define PG8_WAIT_L(n) asm volatile("s_waitcnt lgkmcnt(" #n ")" ::: "memory")
#define PG8_BAR __builtin_amdgcn_s_barrier()
#define PG8_SCHED __builtin_amdgcn_sched_barrier(0)
    Unit cur, nxt; int ui = 0;
    if (!P.next(0, cur)) return;
    f32x4 acc[2][2][4][2];
#pragma unroll
    for (int a = 0; a < 2; ++a)
#pragma unroll
        for (int b = 0; b < 2; ++b)
#pragma unroll
            for (int m = 0; m < 4; ++m)
#pragma unroll
                for (int n = 0; n < 2; ++n) acc[a][b][m][n] = (f32x4){0.f, 0.f, 0.f, 0.f};
    bf16x8 At[4][2], B0[2][2], B1[2][2];
    const char* cA = P.abase(cur); const char* cB = P.bbase(cur);
    unsigned cgo[2][2] = {{0u, 0u}, {0u, 0u}}, ngo[2][2] = {{0u, 0u}, {0u, 0u}};
    if constexpr (Prob::GATHER) P.goffs(cur, sR, sC, cgo);
    PG8_STAGE(PG8_SB(0, 0), cB, voffB); PG8_STAGE(PG8_SB(0, 1), cB + hstep, voffB); PG8_STAGE_A(PG8_SA(0, 0), cA, 0, cgo); PG8_STAGE_A(PG8_SA(0, 1), cA, 1, cgo);
    if (wr == 1) PG8_BAR;
    PG8_WAIT_V(2); PG8_BAR;
    PG8_STAGE(PG8_SB(1, 0), cB + kstep, voffB); PG8_STAGE_A(PG8_SA(1, 0), cA + kstep, 0, cgo); PG8_STAGE(PG8_SB(1, 1), cB + hstep + kstep, voffB);
    PG8_WAIT_V(6); PG8_BAR;
    for (;;) {
        const bool has_next = P.next(ui + 1, nxt);
        const char* nA = has_next ? P.abase(nxt) : cA; const char* nB = has_next ? P.bbase(nxt) : cB;
        if constexpr (Prob::GATHER) {
            if (has_next) P.goffs(nxt, sR, sC, ngo);
            else {
#pragma unroll
                for (int h = 0; h < 2; ++h)
#pragma unroll
                    for (int i = 0; i < 2; ++i) ngo[h][i] = cgo[h][i]; }
        }
        for (int t = 0; t < nt; t += 2) {
            const bool last = (t == nt - 2);
            const char* a1 = cA + (size_t)(t + 1) * kstep;
            const char* a2 = last ? nA : cA + (size_t)(t + 2) * kstep; const char* b2 = last ? nB : cB + (size_t)(t + 2) * kstep;
            const char* a3 = a2 + kstep; const char* b3 = b2 + kstep;
            unsigned g2[2][2];
#pragma unroll
            for (int h = 0; h < 2; ++h)
#pragma unroll
                for (int i = 0; i < 2; ++i) g2[h][i] = last ? ngo[h][i] : cgo[h][i];
            PG8_LDB(B0, 0, 0); PG8_LDB(B1, 0, 1); PG8_SCHED; PG8_LDA(At, 0, 0); PG8_STAGE_A(PG8_SA(1, 1), a1, 1, cgo);
            PG8_WAIT_V(8); PG8_WAIT_L(0); PG8_BAR; PG8_MMA(0, 0, At, B0); PG8_MMA(0, 1, At, B1); PG8_BAR; PG8_SCHED;
            PG8_LDA(At, 0, 1); PG8_STAGE(PG8_SB(0, 0), b2, voffB); PG8_STAGE(PG8_SB(0, 1), b2 + hstep, voffB); PG8_STAGE_A(PG8_SA(0, 0), a2, 0, g2);
            PG8_WAIT_V(8); PG8_WAIT_L(0); PG8_BAR; PG8_MMA(1, 0, At, B0); PG8_MMA(1, 1, At, B1); PG8_BAR; PG8_SCHED;
            PG8_LDB(B0, 1, 0); PG8_LDB(B1, 1, 1); PG8_SCHED; PG8_LDA(At, 1, 0); PG8_STAGE_A(PG8_SA(0, 1), a2, 1, g2);
            PG8_WAIT_V(8); PG8_WAIT_L(0); PG8_BAR; PG8_MMA(0, 0, At, B0); PG8_MMA(0, 1, At, B1); PG8_BAR; PG8_SCHED;
            PG8_LDA(At, 1, 1); PG8_STAGE(PG8_SB(1, 0), b3, voffB); PG8_STAGE(PG8_SB(1, 1), b3 + hstep, voffB); PG8_STAGE_A(PG8_SA(1, 0), a3, 0, g2);
            PG8_WAIT_V(8); PG8_WAIT_L(0); PG8_BAR; PG8_MMA(1, 0, At, B0); PG8_MMA(1, 1, At, B1); PG8_BAR; PG8_SCHED;
        }
        if constexpr (ALIGN_EPI) { if (wr == 0) PG8_BAR; }
        P.epi(acc, cur, wr, wc, fr, fq);
        if (!has_next) break;
        if (!(Prob::CHAIN && P.chain(cur)))
#pragma unroll
        for (int a = 0; a < 2; ++a)
#pragma unroll
            for (int b = 0; b < 2; ++b)
#pragma unroll
                for (int m = 0; m < 4; ++m)
#pragma unroll
                    for (int n = 0; n < 2; ++n) acc[a][b][m][n] = (f32x4){0.f, 0.f, 0.f, 0.f};
        cur = nxt; cA = nA; cB = nB; ++ui;
        if constexpr (Prob::GATHER) {
#pragma unroll
            for (int h = 0; h < 2; ++h)
#pragma unroll
                for (int i = 0; i < 2; ++i) cgo[h][i] = ngo[h][i]; }
        if constexpr (ALIGN_EPI) { if (wr == 1) PG8_BAR; }
    }
    PG8_WAIT_V(0);
    if constexpr (!ALIGN_EPI) { if (wr == 0) PG8_BAR; }
    PG8_BAR;
#undef PG8_SA
#undef PG8_SB
#undef PG8_STAGE
#undef PG8_STAGE_A
#undef PG8_LDA
#undef PG8_LDB
#undef PG8_MMA
#undef PG8_WAIT_V
#undef PG8_WAIT_L
#undef PG8_BAR
#undef PG8_SCHED
}
}
using pg8::Unit;

constexpr size_t TSTEP_D = (size_t)256 * D * 2;
__device__ __forceinline__ int pcu(int cu) { return 32 * (cu >> 6) + 16 * ((cu >> 5) & 1); }
struct ProbInProj {
    static constexpr bool GATHER = false, CHAIN = false; __device__ __forceinline__ bool chain(const Unit&) const { return false; }
    const bf16_t* A; const bf16_t* Bt; int K; pg8::StaticOrder S; rsrc_t wsr;
    __device__ __forceinline__ bool next(int i, Unit& u) const { int pm, pn; if (!S.next(i, pm, pn)) return false; u.pm = pm; u.pn = pn; u.e = 0; u.it = 0; u.ne = 0; return true; }
    __device__ __forceinline__ const char* abase(const Unit& u) const { return (const char*)A + (size_t)u.pm * TSTEP_D; }
    __device__ __forceinline__ const char* bbase(const Unit& u) const { return (const char*)Bt + (size_t)u.pn * TSTEP_D; }
    __device__ __forceinline__ void goffs(const Unit&, const int (&)[2], const int (&)[2], unsigned (&)[2][2]) const {}
    struct Regs {};
    __device__ __forceinline__ void pre(const Unit&, int, int, int, int, Regs&) const {}
    __device__ __forceinline__ void post(const Unit&, int ru, int cu, int fr, int fq, const Regs&, f32x4 va, f32x4 vb) const {
        const unsigned v1 = (unsigned)(fr * (D * 2) + fq * 8), v2 = (unsigned)(fr * (D * 2) + fq * 16), row1 = (unsigned)ru * (unsigned)(D * 2);
        if (cu < 2048) bst4bf(wsr, v1, (unsigned)WS_QA + row1 + (unsigned)pcu(cu) * 2u, va * vb);
        else if (cu < 3072) { bst8bf(wsr, v2, (unsigned)WS_BA + row1 + (unsigned)(cu - 2048) * 2u, va, vb); }
        else if (cu < 5120) { const unsigned zr = (unsigned)(ru + ZPAD + 2 * ZPAD * (ru >= SEQ ? 1 : 0)) * (unsigned)(D * 2); bst4bf(wsr, v1, (unsigned)WS_ZB + zr + (unsigned)pcu(cu - 3072) * 2u, va * sig4(vb)); }
        else if (cu < 7168) { const int cc = cu - 5120; const unsigned so = (cc < 1024 ? (unsigned)WS_U + (unsigned)cc * 2u : (unsigned)WS_V + (unsigned)(cc - 1024) * 2u) + row1;
            const f32x4 ga = gelu4(va), gb = gelu4(vb); bst8bf(wsr, v2, so, ga, gb);
            if (cc >= 1024) {
                float sm = ((ga[0] + ga[1]) + (ga[2] + ga[3])) + ((gb[0] + gb[1]) + (gb[2] + gb[3]));
                float sq = ((ga[0] * ga[0] + ga[1] * ga[1]) + (ga[2] * ga[2] + ga[3] * ga[3])) + ((gb[0] * gb[0] + gb[1] * gb[1]) + (gb[2] * gb[2] + gb[3] * gb[3]));
                sm += __shfl_xor(sm, 16); sq += __shfl_xor(sq, 16); sm += __shfl_xor(sm, 32); sq += __shfl_xor(sq, 32);
                u32x2 w; w.x = __float_as_uint(sm); w.y = __float_as_uint(sq);
                __builtin_amdgcn_raw_buffer_store_b64(w, wsr, fq == 0 ? (unsigned)(fr * 256) : 0xC0000000u, (unsigned)WS_PART + (unsigned)ru * 256u + (unsigned)((cc - 1024) >> 5) * 8u, 0);
            } }
        else { bst8bf(wsr, (unsigned)(fr * (3 * D * 2) + fq * 16), (unsigned)WS_G + (unsigned)ru * (unsigned)(3 * D * 2) + (unsigned)(cu - 7168) * 2u, sig4(va), sig4(vb)); }
    }
    __device__ __forceinline__ void epi(f32x4 (&acc)[2][2][4][2], const Unit& u, int wr, int wc, int fr, int fq) const { pg8::run_epi<1>(*this, acc, u, wr, wc, fr, fq); }
};
struct ProbBranch {
    static constexpr bool GATHER = false, CHAIN = true;
    const unsigned char* ws; int K; pg8::StaticOrder S; rsrc_t wsr;
    __device__ __forceinline__ bool chain(const Unit& u) const { return u.e < 2; }
    __device__ __forceinline__ bool next(int i, Unit& u) const { int pm, pn; if (!S.next(i / 3, pm, pn)) return false; u.pm = pm; u.pn = pn; u.e = i % 3; u.it = 0; u.ne = 0; return true; }
    __device__ __forceinline__ const char* abase(const Unit& u) const { return (const char*)ws + WS_BA + (size_t)u.e * (WS_CB - WS_BA) + (size_t)u.pm * TSTEP_D; }
    __device__ __forceinline__ const char* bbase(const Unit& u) const { return (const char*)ws + WS_WA + (size_t)u.e * (WS_WB - WS_WA) + (size_t)u.pn * TSTEP_D; }
    __device__ __forceinline__ void goffs(const Unit&, const int (&)[2], const int (&)[2], unsigned (&)[2][2]) const {}
    struct Regs { u32x4 g, n; };
    __device__ __forceinline__ void pre(const Unit& u, int ru, int cu, int fr, int fq, Regs& R) const {
        const unsigned v3 = (unsigned)(fr * (3 * D * 2) + fq * 16), sg = (unsigned)WS_G + (unsigned)ru * (unsigned)(3 * D * 2) + (unsigned)(u.e * D + cu) * 2u;
        R.g = __builtin_amdgcn_raw_buffer_load_b128(wsr, v3, sg, 0);
        if (u.e < 2) R.n = __builtin_amdgcn_raw_buffer_load_b128(wsr, v3, sg + (unsigned)(D * 2), 0);
    }
    __device__ __forceinline__ void post(const Unit& u, int ru, int cu, int fr, int fq, const Regs& R, f32x4& va, f32x4& vb) const {
        const f32x4 ga = {bf_lo(R.g.x), bf_hi(R.g.x), bf_lo(R.g.y), bf_hi(R.g.y)}, gb = {bf_lo(R.g.z), bf_hi(R.g.z), bf_lo(R.g.w), bf_hi(R.g.w)};
        if (u.e < 2) {
            const f32x4 na = {bf_lo(R.n.x), bf_hi(R.n.x), bf_lo(R.n.y), bf_hi(R.n.y)}, nb = {bf_lo(R.n.z), bf_hi(R.n.z), bf_lo(R.n.w), bf_hi(R.n.w)};
#pragma unroll
            for (int j = 0; j < 4; ++j) { va[j] = va[j] * ga[j] * __builtin_amdgcn_rcpf(fmaxf(na[j], 1e-30f)); vb[j] = vb[j] * gb[j] * __builtin_amdgcn_rcpf(fmaxf(nb[j], 1e-30f)); }
        } else {
            bst8bf(wsr, (unsigned)(fr * (D * 2) + fq * 16), (unsigned)WS_H + (unsigned)ru * (unsigned)(D * 2) + (unsigned)cu * 2u, va * ga, vb * gb);
        }
    }
    __device__ __forceinline__ void epi(f32x4 (&acc)[2][2][4][2], const Unit& u, int wr, int wc, int fr, int fq) const { pg8::run_epi<4>(*this, acc, u, wr, wc, fr, fq); }
};
struct ProbWo {
    static constexpr bool GATHER = false, CHAIN = false; __device__ __forceinline__ bool chain(const Unit&) const { return false; }
    const bf16_t* A; const bf16_t* Bt; int K; pg8::StaticOrder S;
    rsrc_t wsr;
    __device__ __forceinline__ bool next(int i, Unit& u) const { int pm, pn; if (!S.next(i, pm, pn)) return false; u.pm = pm; u.pn = pn; u.e = 0; u.it = 0; u.ne = 0; return true; }
    __device__ __forceinline__ const char* abase(const Unit& u) const { return (const char*)A + (size_t)u.pm * TSTEP_D; }
    __device__ __forceinline__ const char* bbase(const Unit& u) const { return (const char*)Bt + (size_t)u.pn * TSTEP_D; }
    __device__ __forceinline__ void goffs(const Unit&, const int (&)[2], const int (&)[2], unsigned (&)[2][2]) const {}
    struct Regs {};
    __device__ __forceinline__ void pre(const Unit&, int, int, int, int, Regs&) const {}
    __device__ __forceinline__ void post(const Unit&, int ru, int cu, int fr, int fq, const Regs&, f32x4 va, f32x4 vb) const {
        bst8bf(wsr, (unsigned)(fr * (D * 2) + fq * 16), (unsigned)WS_DELTA + (unsigned)ru * (unsigned)(D * 2) + (unsigned)cu * 2u, va, vb);
    }
    __device__ __forceinline__ void epi(f32x4 (&acc)[2][2][4][2], const Unit& u, int wr, int wc, int fr, int fq) const { pg8::run_epi<1>(*this, acc, u, wr, wc, fr, fq); }
};
constexpr int MOE_TAB_MAX = 192;
__device__ __forceinline__ void moe_build_table(const unsigned* cnt, LAS int* cntL, LAS int* tab, LAS int* ntl, int tid) {
    if (tid < NE) cntL[tid] = (int)ld_agent(cnt + tid);
    __syncthreads();
    if (tid == 0) { int acc = 0; for (int e = 0; e < NE; ++e) { const int nt = (cntL[e] + 255) >> 8; for (int it = 0; it < nt; ++it) tab[acc + it] = (e << 8) | it; acc += nt; } ntl[0] = acc; }
    __syncthreads();
}
__device__ __forceinline__ bool moe_next(int i, int G, int c, int ntiles, const LAS int* tab, const LAS int* cntL, Unit& u) {
    const int L = i * G + c; if (L >= 4 * ntiles) return false;
    const int ti = L >> 2, ent = __builtin_amdgcn_readfirstlane(tab[ti]);
    u.pm = ti; u.pn = L & 3; u.e = ent >> 8; u.it = ent & 255; u.ne = __builtin_amdgcn_readfirstlane(cntL[ent >> 8]); return true;
}
struct ProbMoe1 {
    static constexpr bool GATHER = true, CHAIN = false; __device__ __forceinline__ bool chain(const Unit&) const { return false; }
    const bf16_t* H2; const bf16_t* W13; int K; int G, c;
    const LAS int* cntL; const LAS int* tab; int ntiles;
    rsrc_t wsr;
    __device__ __forceinline__ bool next(int i, Unit& u) const { return moe_next(i, G, c, ntiles, tab, cntL, u); }
    __device__ __forceinline__ const char* abase(const Unit&) const { return (const char*)H2; }
    __device__ __forceinline__ const char* bbase(const Unit& u) const { return (const char*)W13 + ((size_t)u.e * 1024 + (size_t)u.pn * 256) * D * 2; }
    __device__ __forceinline__ void goffs(const Unit& u, const int (&R)[2], const int (&C)[2], unsigned (&o)[2][2]) const {
#pragma unroll
        for (int h = 0; h < 2; ++h)
#pragma unroll
            for (int i = 0; i < 2; ++i) {
                const int idx = u.it * 256 + h * 128 + R[i];
                const int tok = (int)__builtin_amdgcn_raw_buffer_load_b32(wsr, (unsigned)(R[i] * 4), (unsigned)WS_STOK + (unsigned)(u.e * CAP + u.it * 256 + h * 128) * 4u, 0);
                o[h][i] = (unsigned)((idx < u.ne ? tok : T) * D + C[i]) * 2u;
            }
    }
    struct Regs { unsigned rs; };
    __device__ __forceinline__ void pre(const Unit& u, int ru, int, int fr, int, Regs& R) const {
        R.rs = __builtin_amdgcn_raw_buffer_load_b32(wsr, (unsigned)(fr * 4), (unsigned)WS_SRS + (unsigned)(u.e * CAP + u.it * 256 + (ru - u.pm * 256)) * 4u, 0);
    }
    __device__ __forceinline__ void post(const Unit& u, int ru, int cu, int fr, int fq, const Regs& R, f32x4 va, f32x4 vb) const {
        const float rs = (u.it * 256 + (ru - u.pm * 256) + fr) < u.ne ? __uint_as_float(R.rs) : 0.f;
        bst4bf(wsr, (unsigned)(fr * (DFF * 2) + fq * 8), (unsigned)WS_ACT + (unsigned)ru * (unsigned)(DFF * 2) + (unsigned)pcu(cu) * 2u, silu4(va * rs) * (vb * rs));
    }
    __device__ __forceinline__ void epi(f32x4 (&acc)[2][2][4][2], const Unit& u, int wr, int wc, int fr, int fq) const { pg8::run_epi<4>(*this, acc, u, wr, wc, fr, fq); }
};
struct ProbMoe2 {
    static constexpr bool GATHER = false, CHAIN = false; __device__ __forceinline__ bool chain(const Unit&) const { return false; }
    const bf16_t* ACT; const bf16_t* W2; int K; int G, c;
    const LAS int* cntL; const LAS int* tab; int ntiles;
    rsrc_t wsr;
    __device__ __forceinline__ bool next(int i, Unit& u) const { return moe_next(i, G, c, ntiles, tab, cntL, u); }
    __device__ __forceinline__ const char* abase(const Unit& u) const { return (const char*)ACT + (size_t)u.pm * 256 * DFF * 2; }
    __device__ __forceinline__ const char* bbase(const Unit& u) const { return (const char*)W2 + ((size_t)u.e * 1024 + (size_t)u.pn * 256) * DFF * 2; }
    __device__ __forceinline__ void goffs(const Unit&, const int (&)[2], const int (&)[2], unsigned (&)[2][2]) const {}
    struct Regs { unsigned w, asg; };
    __device__ __forceinline__ void pre(const Unit& u, int ru, int, int fr, int, Regs& R) const {
        const unsigned ss = (unsigned)(u.e * CAP + u.it * 256 + (ru - u.pm * 256)) * 4u;
        R.w = __builtin_amdgcn_raw_buffer_load_b32(wsr, (unsigned)(fr * 4), (unsigned)WS_SW + ss, 0); R.asg = __builtin_amdgcn_raw_buffer_load_b32(wsr, (unsigned)(fr * 4), (unsigned)WS_SASG + ss, 0);
    }
    __device__ __forceinline__ void post(const Unit& u, int ru, int cu, int fr, int fq, const Regs& R, f32x4 va, f32x4 vb) const {
        const int idx = u.it * 256 + (ru - u.pm * 256) + fr;
        const float w = __uint_as_float(R.w);
        const unsigned v = idx < u.ne ? R.asg * (unsigned)(D * 2) + (unsigned)(fq * 16) : 0xC0000000u;
        const unsigned so = (unsigned)WS_YC + (unsigned)cu * 2u;
        bst4bf(wsr, v, so, va * w); bst4bf(wsr, v + 8u, so, vb * w);
    }
    __device__ __forceinline__ void epi(f32x4 (&acc)[2][2][4][2], const Unit& u, int wr, int wc, int fr, int fq) const { pg8::run_epi<4>(*this, acc, u, wr, wc, fr, fq); }
};

#define XB_TMO      128
#define XB_XCNT(j)  (256  + 64 * (j))
#define XB_XSUB(j)  (1280 + 64 * (j))
#define XB_XGEN(j)  (2304 + 64 * (j))
#define XB_TOP      3328
#define XB_TOPGEN   3392
#define XCD_BAR_WORDS 3456
#define XB_SPIN_CAP (1u << 18)
__device__ __forceinline__ unsigned xb_ld(unsigned* p)              { return __hip_atomic_load(p, __ATOMIC_RELAXED, __HIP_MEMORY_SCOPE_AGENT); }
__device__ __forceinline__ unsigned xb_add(unsigned* p, unsigned v) { return __hip_atomic_fetch_add(p, v, __ATOMIC_RELAXED, __HIP_MEMORY_SCOPE_AGENT); }
__device__ __forceinline__ unsigned xb_xcc_id() { return (unsigned)__builtin_amdgcn_s_getreg((3 << 11) | 20) & 0xFu; }
#define XB_SPIN(cond, bar) do { unsigned _sp = 0; while (cond) { __builtin_amdgcn_s_sleep(1); \
    if ((++_sp & 255u) == 0u) { if (xb_ld(&(bar)[XB_TMO])) break; if (_sp > XB_SPIN_CAP) { atomicAdd(&(bar)[XB_TMO], 1u); break; } } } } while (0)
struct XcdBarrier {
    unsigned* bar; unsigned x;
    volatile LAS unsigned* st;
};
__device__ __forceinline__ XcdBarrier xcd_barrier_post(unsigned* bar, volatile LAS unsigned* st) {
    XcdBarrier b; b.bar = bar; b.x = xb_xcc_id(); b.st = st;
    if (threadIdx.x == 0) (void)xb_add(&bar[XB_XCNT(b.x)], 1u);
    return b;
}
__device__ __forceinline__ void xcd_barrier_complete(unsigned* bar, unsigned x, unsigned& nloc, unsigned& nx) {
    const unsigned G = gridDim.x * gridDim.y * gridDim.z;
    unsigned sum, cnt, mine, sp = 0u;
    for (;;) {
        sum = 0u; cnt = 0u; mine = 0u;
#pragma unroll
        for (unsigned j = 0; j < 16; ++j) { const unsigned c = xb_ld(&bar[XB_XCNT(j)]); sum += c; cnt += (c > 0u) ? 1u : 0u; mine = (j == x) ? c : mine; }
        if (sum == G) break;
        __builtin_amdgcn_s_sleep(1);
        if ((++sp & 255u) == 0u) { if (xb_ld(&bar[XB_TMO])) break; if (sp > XB_SPIN_CAP) { atomicAdd(&bar[XB_TMO], 1u); break; } }
    }
    nloc = mine > 0u ? mine : 1u; nx = cnt > 0u ? cnt : 1u;
}
__device__ __forceinline__ void xcd_barrier(const XcdBarrier& b) {
    asm volatile("s_waitcnt vmcnt(0)" ::: "memory");
    __syncthreads();
    if (threadIdx.x == 0) {
        unsigned* bar = b.bar;
        __builtin_amdgcn_s_waitcnt(0);
        unsigned nloc = b.st[0], nx = b.st[1];
        if (nloc == 0u) { xcd_barrier_complete(bar, b.x, nloc, nx); b.st[0] = nloc; b.st[1] = nx; }
        const unsigned old = xb_add(&bar[XB_XSUB(b.x)], 1u);
        const unsigned gen = old / nloc;
        if (old + 1u == (gen + 1u) * nloc) {
            __builtin_amdgcn_fence(__ATOMIC_RELEASE, "agent");
            asm volatile("s_waitcnt vmcnt(0)" ::: "memory");
            const unsigned og = xb_add(&bar[XB_TOP], 1u);
            const unsigned tg = og / nx;
            if (og + 1u == (tg + 1u) * nx) xb_add(&bar[XB_TOPGEN], 1u);
            else XB_SPIN(xb_ld(&bar[XB_TOPGEN]) == tg, bar);
            __builtin_amdgcn_fence(__ATOMIC_ACQUIRE, "agent");
            xb_add(&bar[XB_XGEN(b.x)], 1u);
            asm volatile("s_waitcnt vmcnt(0)" ::: "memory");
        } else {
            XB_SPIN(xb_ld(&bar[XB_XGEN(b.x)]) == gen, bar);
            __builtin_amdgcn_fence(__ATOMIC_ACQUIRE, "agent");
            asm volatile("s_waitcnt vmcnt(0)" ::: "memory");
        }
    }
    __syncthreads();
}

static_assert(MOE_OFF + (32 + MOE_TAB_MAX + 4) * 4 <= RT_LOG && MID_LDS <= RING_BYTES && 256 * 65 * 4 <= RING_BYTES, "LDS map");
static_assert(WS_U - WS_CB == WS_CB - WS_BA && WS_WC - WS_WB == WS_WB - WS_WA, "branch operands equally spaced");
constexpr int NPH = 8 * NL + 1;

struct Args { const float* in[24]; float* out; unsigned char* ws; int ph_lo, ph_hi, bar_region, pad; CvtTable tb[NL]; };
#define WSA(type, off) ((type*)(a->ws + (off)))
#define KARGS() ({ const CAS Args* q_ = kp; asm volatile("" : "+s"(q_)); q_; })

#ifndef PROBE_MASK
#define PROBE_MASK 0
#endif
__global__ void __launch_bounds__(512, 2) mk_fwd(Args a_unused) {
    extern __shared__ __attribute__((aligned(16))) unsigned char lds_[];
    LAS unsigned char* lds = (LAS unsigned char*)lds_;
    volatile LAS unsigned* MISC = (volatile LAS unsigned*)(lds + MISC_OFF);
    for (int u = threadIdx.x; u < (LDS_BYTES - LDSCTL_OFF) / 4; u += 512) ((LAS unsigned*)(lds + LDSCTL_OFF))[u] = 0u;
    __syncthreads();
    const CAS Args* kp = (const CAS Args*)__builtin_amdgcn_kernarg_segment_ptr();
    int lo, hi; XcdBarrier bar;
    { const CAS Args* a = KARGS(); lo = a->ph_lo; hi = a->ph_hi; bar = xcd_barrier_post(WSA(unsigned, WS_CTL) + CW_BAR + a->bar_region * XCD_BAR_WORDS, MISC + 8); }
#ifndef PHMASK
#define PHMASK 0x1ff
#endif
#define IN(k) (((PHMASK >> (((k) == 8 * NL) ? 8 : ((k) & 7))) & 1) && lo <= (k) && (k) < hi)
#define PHASE_REGS() int tid = threadIdx.x; asm volatile("" : "+v"(tid)); int bid = blockIdx.x, G = gridDim.x; asm volatile("" : "+s"(bid), "+s"(G))
#define SEAM(k) do { if ((k) + 1 < hi) xcd_barrier(bar); } while (0)
    LAS int* cntL = (LAS int*)(lds + MOE_OFF); LAS int* tabL = cntL + 32; LAS int* ntl = tabL + MOE_TAB_MAX;
    unsigned long long probe_t = 0ull, probe_t0 = 0ull; (void)probe_t0;
#define PB(j) do { if ((PROBE_MASK >> (j)) & 1) probe_t0 = __builtin_amdgcn_s_memrealtime(); } while (0)
#define PE(j) do { if ((PROBE_MASK >> (j)) & 1) probe_t += __builtin_amdgcn_s_memrealtime() - probe_t0; } while (0)

    for (int l = 0; l < NL; ++l) {
        const int k0 = 8 * l;
        if (IN(k0 + 0)) { PB(0);
            PHASE_REGS(); const CAS Args* a = KARGS(); bf16_t* const Hb = WSA(bf16_t, WS_H); unsigned* const ctl = WSA(unsigned, WS_CTL); (void)ctl; (void)Hb;
            if (l == 0) cvt_phase(&a->tb[0], 0, NCVT, G, 0, (LAS float*)lds, tid, bid, G);
            if (l == 0 && bid < 4) { unsigned* z = WSA(unsigned, WS_ZB) + (size_t)((bid >> 1) * ZSEQ + (bid & 1) * (SEQ + ZPAD)) * (D / 2); for (int i = tid; i < ZPAD * D / 2; i += 512) z[i] = 0u; }
            { const int row = bid * 8 + (tid >> 6); if (row < NHC * 128) { const float* wp = a->in[11] + ((size_t)l * NHC * 128 + row) * 128 + (tid & 63); const float sm = wave_sum(wp[0] + wp[64]); if ((tid & 63) == 0) WSA(float, WS_STAT)[row] = sm; } }
            if (l == 0) norm_phase<false, false>(a->in[0], nullptr, nullptr, a->in[1], Hb, nullptr, tid, bid, G);
            else norm_phase<true, false>(a->out, a->out, WSA(bf16_t, WS_YC), a->in[1] + l * D, Hb, nullptr, tid, bid, G);
            SEAM(k0 + 0); PE(0);
        }
        if (IN(k0 + 1)) { PB(1);
            PHASE_REGS(); const CAS Args* a = KARGS(); bf16_t* const Hb = WSA(bf16_t, WS_H); unsigned* const ctl = WSA(unsigned, WS_CTL); (void)ctl; (void)Hb;
            ProbInProj P; P.A = Hb; P.Bt = WSA(bf16_t, WS_WIN); P.K = D; P.S.init(T, DIN, G, bid);
            P.wsr = mkrsrc(a->ws, (unsigned)WS_END);
            pg8::gemm_phase<ProbInProj, true>(lds, P, tid);
            SEAM(k0 + 1); PE(1);
        }
        if (IN(k0 + 2)) { PB(2);
            PHASE_REGS(); const CAS Args* a = KARGS(); bf16_t* const Hb = WSA(bf16_t, WS_H); unsigned* const ctl = WSA(unsigned, WS_CTL); (void)ctl; (void)Hb;
            mid_phase(mkrsrc(a->ws, (unsigned)WS_END), a->ws, WSA(bf16_t, WS_V),
                      a->in[3] + (size_t)l * 3 * D, a->in[5] + (size_t)l * 31 * D, a->in[6] + l * D, a->in[7] + l * D, a->in[9] + l * D, a->in[10] + l * D,
                      a->in[11] + (size_t)l * NHC * 128 * 128, a->in[12] + l * NHC * 128, WSA(float, WS_STAT), lds, tid, bid, G, probe_t);
            SEAM(k0 + 2); PE(2);
        }
        if (IN(k0 + 3)) { PB(3);
            PHASE_REGS(); const CAS Args* a = KARGS(); bf16_t* const Hb = WSA(bf16_t, WS_H); unsigned* const ctl = WSA(unsigned, WS_CTL); (void)ctl; (void)Hb;
            ProbBranch P; P.ws = a->ws;
            P.K = D; P.S.init(T, D, G, bid); P.wsr = mkrsrc(a->ws, (unsigned)WS_END);
            pg8::gemm_phase<ProbBranch, true>(lds, P, tid);
            SEAM(k0 + 3); PE(3);
        }
        if (IN(k0 + 4)) { PB(4);
            PHASE_REGS(); const CAS Args* a = KARGS(); bf16_t* const Hb = WSA(bf16_t, WS_H); unsigned* const ctl = WSA(unsigned, WS_CTL); (void)ctl; (void)Hb;
            ProbWo P; P.A = Hb; P.Bt = WSA(bf16_t, WS_WO); P.K = D; P.S.init(T, D, G, bid); P.wsr = mkrsrc(a->ws, (unsigned)WS_END);
            pg8::gemm_phase<ProbWo, false>(lds, P, tid);
            SEAM(k0 + 4); PE(4);
        }
        if (IN(k0 + 5)) { PB(5);
            PHASE_REGS(); const CAS Args* a = KARGS(); bf16_t* const Hb = WSA(bf16_t, WS_H); unsigned* const ctl = WSA(unsigned, WS_CTL); (void)ctl; (void)Hb;
            router_phase(mkrsrc((l == 0) ? a->in[0] : a->out, (unsigned)((size_t)T * D * 4)), mkrsrc(a->out, (unsigned)((size_t)T * D * 4)), mkrsrc(a->in[15] + l * D, D * 4), mkrsrc(a->in[16] + (size_t)l * D * NG, D * NG * 4), mkrsrc(a->ws, (unsigned)WS_END), a->in[17] + l * NG, a->in[18] + (size_t)l * D * NE, a->in[19] + l * NE,
                         Hb, ctl + CW_CNT + 64 * l, WSA(int, WS_STOK), WSA(float, WS_SW), WSA(int, WS_SASG), WSA(float, WS_SRS), lds, tid, bid, G);
            SEAM(k0 + 5); PE(5);
        }
        if (IN(k0 + 6)) { PB(6);
            PHASE_REGS(); const CAS Args* a = KARGS(); bf16_t* const Hb = WSA(bf16_t, WS_H); unsigned* const ctl = WSA(unsigned, WS_CTL); (void)ctl; (void)Hb;
            moe_build_table(ctl + CW_CNT + 64 * l, cntL, tabL, ntl, tid);
            ProbMoe1 P; P.H2 = Hb; P.W13 = WSA(bf16_t, WS_W13); P.K = D; P.G = G; P.c = bid; P.cntL = cntL; P.tab = tabL; P.ntiles = __builtin_amdgcn_readfirstlane(ntl[0]); P.wsr = mkrsrc(a->ws, (unsigned)WS_END);
            pg8::gemm_phase<ProbMoe1, true>(lds, P, tid);
            if (l + 1 < NL) { const int rem = (4 * P.ntiles) % G; cvt_phase(&a->tb[l + 1], 0, NCVT - 1, rem == 0 ? G : rem, 8, (LAS float*)lds, tid, bid, G); }
            SEAM(k0 + 6); PE(6);
        }
        if (IN(k0 + 7)) { PB(7);
            PHASE_REGS(); const CAS Args* a = KARGS(); bf16_t* const Hb = WSA(bf16_t, WS_H); unsigned* const ctl = WSA(unsigned, WS_CTL); (void)ctl; (void)Hb;
            moe_build_table(ctl + CW_CNT + 64 * l, cntL, tabL, ntl, tid);
            ProbMoe2 P; P.ACT = WSA(bf16_t, WS_ACT); P.W2 = (l & 1) ? WSA(bf16_t, WS_W2B) : WSA(bf16_t, WS_W2); P.K = DFF; P.G = G; P.c = bid; P.cntL = cntL; P.tab = tabL; P.ntiles = __builtin_amdgcn_readfirstlane(ntl[0]); P.wsr = mkrsrc(a->ws, (unsigned)WS_END);
            pg8::gemm_phase<ProbMoe2, true>(lds, P, tid);
            if (l + 1 < NL) { const int rem = (4 * P.ntiles) % G; cvt_phase(&a->tb[l + 1], NCVT - 1, NCVT, rem == 0 ? G : rem, 4, (LAS float*)lds, tid, bid, G); }
            SEAM(k0 + 7); PE(7);
        }
    }
    if (IN(8 * NL)) { PHASE_REGS(); const CAS Args* a = KARGS(); norm_phase<true, true>(a->out, nullptr, WSA(bf16_t, WS_YC), a->in[23], nullptr, a->out, tid, bid, G); }
    if ((PROBE_MASK != 0 || PROBE_MID != 0) && blockIdx.x == 0) { const unsigned long long t = __builtin_amdgcn_s_memrealtime(); while (__builtin_amdgcn_s_memrealtime() - t < probe_t) __builtin_amdgcn_s_sleep(8); }
#undef IN
#undef SEAM
}

static void build_cvt(CvtTable& tb, void* const* d_in, unsigned char* ws, int l) {
    const float* w_in = (const float*)d_in[2] + (size_t)l * D * DIN;
    auto set = [&](int i, const float* A, const float* B, bf16_t* dst, int ld, int K, int ndst, int pair, int cA, int cB, int batch, long sb, long db) {
        CvtDesc& c = tb.d[i]; c.A = A; c.B = B; c.dst = dst; c.ld = ld; c.K = K; c.ndst = ndst; c.pair = pair; c.colA0 = cA; c.colB0 = cB; c.batch = batch; c.sbatch = sb; c.dbatch = db;
        c.items = batch * (ndst / 64) * (K / 256); };
    bf16_t* win = (bf16_t*)(ws + WS_WIN);
    set(0, w_in, w_in, win, DIN, D, 2048, 1, 0, 2048, 1, 0, 0);
    set(1, w_in, nullptr, win + (size_t)2048 * D, DIN, D, 1024, 0, 1024, 0, 1, 0, 0);
    set(2, w_in, w_in, win + (size_t)3072 * D, DIN, D, 2048, 1, 3072, 4096, 1, 0, 0);
    set(3, w_in, nullptr, win + (size_t)5120 * D, DIN, D, 2048, 0, 5120, 0, 1, 0, 0);
    set(4, w_in, nullptr, win + (size_t)7168 * D, DIN, D, 3072, 0, 7168, 0, 1, 0, 0);
    set(5, (const float*)d_in[4] + (size_t)l * D * D, nullptr, (bf16_t*)(ws + WS_WA), D, D, D, 0, 0, 0, 1, 0, 0);
    set(6, (const float*)d_in[8] + (size_t)l * D * D, nullptr, (bf16_t*)(ws + WS_WB), D, D, D, 0, 0, 0, 1, 0, 0);
    set(7, (const float*)d_in[13] + (size_t)l * D * D, nullptr, (bf16_t*)(ws + WS_WC), D, D, D, 0, 0, 0, 1, 0, 0);
    set(8, (const float*)d_in[14] + (size_t)l * D * D, nullptr, (bf16_t*)(ws + WS_WO), D, D, D, 0, 0, 0, 1, 0, 0);
    set(9, (const float*)d_in[22] + (size_t)l * NE * DFF * D, nullptr, (bf16_t*)(ws + ((l & 1) ? WS_W2B : WS_W2)), D, DFF, D, 0, 0, 0, NE, (long)DFF * D, (long)D * DFF);
    set(10, (const float*)d_in[20] + (size_t)l * NE * D * DFF, (const float*)d_in[21] + (size_t)l * NE * D * DFF, (bf16_t*)(ws + WS_W13), DFF, D, 1024, 1, 0, 0, NE, (long)D * DFF, (long)1024 * D);
    tb.total = 0; for (int i = 0; i < NCVT; ++i) tb.total += tb.d[i].items; tb.pad = 0;
}

#ifndef MK_CUTS
#define MK_CUTS 0
#endif

extern "C" void kernel_launch(void* const* d_in, const int* in_sizes, int n_in, void* d_out, int out_size, void* d_ws, size_t ws_size, hipStream_t stream) {
    static int grid = 0;
    if (grid == 0) {
        if (n_in != 24 || ws_size < WS_END) { fprintf(stderr, "kernel_launch: unexpected n_in %d or ws_size %zu < %zu\n", n_in, ws_size, (size_t)WS_END); grid = -1; return; }
        int dev = 0, cus = 0, per_cu = 0;
        if (hipGetDevice(&dev) != hipSuccess || hipDeviceGetAttribute(&cus, hipDeviceAttributeMultiprocessorCount, dev) != hipSuccess) { grid = -1; return; }
        if (hipFuncSetAttribute((const void*)mk_fwd, hipFuncAttributeMaxDynamicSharedMemorySize, LDS_BYTES) != hipSuccess) { fprintf(stderr, "kernel_launch: hipFuncSetAttribute failed\n"); grid = -1; return; }
        if (hipOccupancyMaxActiveBlocksPerMultiprocessor(&per_cu, (const void*)mk_fwd, 512, LDS_BYTES) != hipSuccess || per_cu < 1) { fprintf(stderr, "kernel_launch: occupancy query says %d\n", per_cu); }
        (void)hipGetLastError();
        grid = cus;
    }
    if (grid < 0) return;
    unsigned char* ws = (unsigned char*)d_ws;
    (void)hipMemsetAsync(ws + WS_CTL, 0, CTL_BYTES, stream);
    Args a{};
    for (int i = 0; i < 24; ++i) a.in[i] = (const float*)d_in[i];
    a.out = (float*)d_out; a.ws = ws;
    for (int l = 0; l < NL; ++l) build_cvt(a.tb[l], d_in, ws, l);
#if MK_CUTS == 0
    a.ph_lo = 0; a.ph_hi = NPH; a.bar_region = 0;
    hipLaunchKernelGGL(mk_fwd, dim3(grid), dim3(512), LDS_BYTES, stream, a);
#elif MK_CUTS == 1
    for (int k = 0; k < NPH; ++k) { a.ph_lo = k; a.ph_hi = k + 1; a.bar_region = 0; hipLaunchKernelGGL(mk_fwd, dim3(grid), dim3(512), LDS_BYTES, stream, a); }
#else
    a.ph_lo = 0; a.ph_hi = 8; a.bar_region = 0; hipLaunchKernelGGL(mk_fwd, dim3(grid), dim3(512), LDS_BYTES, stream, a);
    a.ph_lo = 8; a.ph_hi = NPH; a.bar_region = 1; hipLaunchKernelGGL(mk_fwd, dim3(grid), dim3(512), LDS_BYTES, stream, a);
#endif
}
```
